# Optimizing an MI355X kernel written in HIP

```python
import math
import jax, jax.numpy as jnp
from jax import lax
import numpy as np

D_MODEL = 1024
BATCH = 32
SEQ = 256
DEPTH = 2
DEC_BATCH = 2
DEC_SEQ = 2048
PAST_LEN = 256

GRID_W = 64
N_HEADS = 16
HEAD_DIM = D_MODEL // N_HEADS
WIN_ROWS = 8
WIN_COLS = 16
Q_COLS = 16
K_COLS = 32
CTX_Q_BLOCK = 128
D_FF = 2816
N_MIXERS = 2
N_ATTN_LAYERS = (DEPTH + 1) // 2
N_HYENA_LAYERS = DEPTH // 2
N_MOD = 9
HY_ORDER = 2
HY_DIRS = 2
HY_SHORT = 3
HY_BANDS = 16
HY_EMB = 1 + 2 * HY_BANDS
HY_FILTER_W = 64
HY_FAST_DECAY = 0.3
HY_SLOW_DECAY = 1.5
HY_TARGET = 1e-2
ALPHA = (2 * DEPTH) ** 0.25
BETA = (8 * DEPTH) ** -0.25
LN_EPS = 1e-5

kernel_name = "hybrid_natten_hyena_diffusion_step"


def layer_norm(x, g, b):
    xf = x.astype(jnp.float32)
    mu = xf.mean(-1, keepdims=True)
    var = jnp.square(xf - mu).mean(-1, keepdims=True)
    return ((xf - mu) * lax.rsqrt(var + LN_EPS) * g + b).astype(x.dtype)


def modulate(x, shift, scale):
    return x * (1.0 + scale) + shift


def swiglu(h, w_in, w_out):
    g, u = jnp.split(h @ w_in, 2, axis=-1)
    return (jax.nn.silu(g) * u) @ w_out


def attention_context(h, w_qkv, w_o):
    B, S, _ = h.shape
    q, k, v = [t.reshape(B, S, N_HEADS, HEAD_DIM) for t in jnp.split(h @ w_qkv, 3, axis=-1)]
    qb = jnp.moveaxis((q * HEAD_DIM ** -0.5).reshape(B, S // CTX_Q_BLOCK, CTX_Q_BLOCK, N_HEADS, HEAD_DIM), 1, 0)

    def block(q_blk):
        s = jnp.einsum('bqhd,bkhd->bhqk', q_blk, k).astype(jnp.float32)
        p = jax.nn.softmax(s, axis=-1).astype(v.dtype)
        return jnp.einsum('bhqk,bkhd->bqhd', p, v)

    o = jnp.moveaxis(lax.map(block, qb), 0, 1).reshape(B, S, D_MODEL)
    return o @ w_o, k, v


def attention_latent(h, k_ctx, v_ctx, w_qkv, w_o, rpb):
    B, L, _ = h.shape
    rows = L // GRID_W
    kr = min(WIN_ROWS, rows)
    n_cb = GRID_W // Q_COLS
    q, k, v = [t.reshape(B, rows, GRID_W, N_HEADS, HEAD_DIM) for t in jnp.split(h @ w_qkv, 3, axis=-1)]
    q = q * HEAD_DIM ** -0.5
    qcol = np.arange(GRID_W).reshape(n_cb, Q_COLS)
    cstart = np.clip(qcol - WIN_COLS // 2, 0, GRID_W - WIN_COLS)
    kstart = np.clip(cstart[:, 0], 0, GRID_W - K_COLS)
    kcol = kstart[:, None] + np.arange(K_COLS)
    col_ok = (kcol[:, None, :] >= cstart[:, :, None]) & (kcol[:, None, :] < cstart[:, :, None] + WIN_COLS)
    dcol = np.clip(kcol[:, None, :] - qcol[:, :, None], 1 - WIN_COLS, WIN_COLS - 1) + WIN_COLS - 1
    bias_col = rpb[:, :, dcol]
    mask = jnp.asarray(col_ok)[None, None, :, :, None, :]
    n_lat = kr * K_COLS

    def one_row(args):
        r, q_r = args
        rs = jnp.clip(r - kr // 2, 0, rows - kr)
        k_blk = lax.dynamic_slice_in_dim(k, rs, kr, axis=1)[:, :, kcol]
        v_blk = lax.dynamic_slice_in_dim(v, rs, kr, axis=1)[:, :, kcol]
        drow = rs + jnp.arange(kr) - r + WIN_ROWS - 1
        bias = bias_col[:, drow].transpose(0, 2, 3, 1, 4)
        q_b = q_r.reshape(B, n_cb, Q_COLS, N_HEADS, HEAD_DIM)
        s_lat = jnp.einsum('bnqhd,brnkhd->bhnqrk', q_b, k_blk).astype(jnp.float32) + bias
        s_lat = jnp.where(mask, s_lat, -jnp.inf).reshape(B, N_HEADS, n_cb, Q_COLS, n_lat)
        s_ctx = jnp.einsum('bnqhd,bshd->bhnqs', q_b, k_ctx).astype(jnp.float32)
        p = jax.nn.softmax(jnp.concatenate([s_lat, s_ctx], axis=-1), axis=-1).astype(v.dtype)
        p_lat = p[..., :n_lat].reshape(B, N_HEADS, n_cb, Q_COLS, kr, K_COLS)
        o = (jnp.einsum('bhnqrk,brnkhd->bnqhd', p_lat, v_blk)
             + jnp.einsum('bhnqs,bshd->bnqhd', p[..., n_lat:], v_ctx))
        return o.reshape(B, GRID_W, D_MODEL)

    o = lax.map(one_row, (jnp.arange(rows), jnp.moveaxis(q, 1, 0)))
    return jnp.moveaxis(o, 0, 1).reshape(B, L, D_MODEL) @ w_o


def short_conv(u, w, b):
    up = jnp.pad(u, ((0, 0), (1, 1), (0, 0)))
    return up[:, :-2] * w[0] + up[:, 1:-1] * w[1] + up[:, 2:] * w[2] + b


def hyena_filters(L, f_w1, f_b1, f_freq1, f_w2, f_b2, f_freq2, f_w3, f_b3):
    pos = jnp.arange(L, dtype=jnp.float32)[:, None]
    t = pos / max(L - 1, 1)
    bands = jnp.linspace(1e-4, HY_BANDS - 1, HY_BANDS, dtype=jnp.float32)
    ang = 2.0 * math.pi * pos / L * bands
    z = jnp.concatenate([t, jnp.cos(ang), -jnp.sin(ang)], axis=-1)
    hid = jnp.sin(f_freq1 * (z @ f_w1 + f_b1))
    hid = jnp.sin(f_freq2 * (hid @ f_w2 + f_b2))
    filt = (hid @ f_w3 + f_b3).reshape(L, HY_ORDER, HY_DIRS, D_MODEL).astype(jnp.float32)
    deltas = jnp.abs(jnp.linspace(math.log(HY_TARGET) / HY_SLOW_DECAY, math.log(HY_TARGET) / HY_FAST_DECAY,
                                  D_MODEL, dtype=jnp.float32))
    return filt * jnp.exp(-t.reshape(L, 1, 1, 1) * deltas)


def long_conv(z, h_fwd, h_bwd, bias):
    L = z.shape[1]
    k = jnp.concatenate([h_fwd, jnp.zeros_like(h_fwd[:1]), h_bwd[:0:-1]], axis=0)
    zf = z.astype(jnp.float32)
    y = jnp.fft.irfft(jnp.fft.rfft(zf, n=2 * L, axis=1) * jnp.fft.rfft(k, n=2 * L, axis=0)[None],
                      n=2 * L, axis=1)[:, :L]
    return (y + zf * bias).astype(z.dtype)


def hyena(h, w_in, conv_w, conv_b, f_w1, f_b1, f_freq1, f_w2, f_b2, f_freq2, f_w3, f_b3, bias, w_out):
    L = h.shape[1]
    v, x1, x2 = jnp.split(short_conv(h @ w_in, conv_w, conv_b), 3, axis=-1)
    filt = hyena_filters(L, f_w1, f_b1, f_freq1, f_w2, f_b2, f_freq2, f_w3, f_b3)
    z = long_conv(v, filt[:, 0, 0], filt[:, 0, 1], bias[0]) * x1
    z = long_conv(z, filt[:, 1, 0], filt[:, 1, 1], bias[1]) * x2
    return z @ w_out


def trunk_layer(x, cond, mod_w_i, mod_b_i, ln_g_i, ln_b_i, ffn_w_in_i, ffn_w_out_i, mixer):
    sh1, sc1, g1, sh2, sc2, g2, sh3, sc3, g3 = jnp.split(jax.nn.silu(cond) @ mod_w_i + mod_b_i, N_MOD, axis=-1)
    x = layer_norm(ALPHA * x + 0.5 * g1 * swiglu(modulate(x, sh1, sc1), ffn_w_in_i[0], ffn_w_out_i[0]),
                   ln_g_i[0], ln_b_i[0])
    mix, extras = mixer(modulate(x, sh2, sc2))
    x = layer_norm(ALPHA * x + g2 * mix, ln_g_i[1], ln_b_i[1])
    x = layer_norm(ALPHA * x + 0.5 * g3 * swiglu(modulate(x, sh3, sc3), ffn_w_in_i[1], ffn_w_out_i[1]),
                   ln_g_i[2], ln_b_i[2])
    return x, extras


def setup_inputs(seed: int = 0) -> dict:
    key = jax.random.key(seed)
    ks = jax.random.split(key, 28)
    D = D_MODEL
    hd = HY_ORDER * HY_DIRS * D_MODEL

    def nrm(k, shape, s):
        return jax.random.normal(k, shape, jnp.float32) * s

    return {
        "x_prompt": nrm(ks[0], (BATCH, SEQ, D), 1.0),
        "x_sample": nrm(ks[1], (DEC_BATCH, DEC_SEQ, D), 1.0),
        "cache_k": nrm(ks[2], (DEC_BATCH, N_ATTN_LAYERS, PAST_LEN, N_HEADS, HEAD_DIM), 1.0),
        "cache_v": nrm(ks[3], (DEC_BATCH, N_ATTN_LAYERS, PAST_LEN, N_HEADS, HEAD_DIM), 1.0),
        "c": nrm(ks[4], (DEC_BATCH, D), 1.0),
        "c_ctx": nrm(ks[5], (D,), 1.0),
        "mod_w": nrm(ks[6], (DEPTH, D, N_MOD * D), 0.5 * D ** -0.5),
        "mod_b": nrm(ks[7], (DEPTH, N_MOD * D), 0.01),
        "ln_g": 1.0 + nrm(ks[8], (DEPTH, 3, D), 0.05),
        "ln_b": nrm(ks[9], (DEPTH, 3, D), 0.02),
        "ffn_w_in": nrm(ks[10], (DEPTH, 2, D, 2 * D_FF), D ** -0.5),
        "ffn_w_out": nrm(ks[11], (DEPTH, 2, D_FF, D), BETA * D_FF ** -0.5),
        "attn_w_qkv": nrm(ks[12], (N_ATTN_LAYERS, D, 3 * D), D ** -0.5),
        "attn_w_o": nrm(ks[13], (N_ATTN_LAYERS, D, D), BETA * D ** -0.5),
        "attn_rpb": nrm(ks[14], (N_ATTN_LAYERS, N_HEADS, 2 * WIN_ROWS - 1, 2 * WIN_COLS - 1), 0.1),
        "hy_w_in": nrm(ks[15], (N_HYENA_LAYERS, D, 3 * D), D ** -0.5),
        "hy_conv_w": nrm(ks[16], (N_HYENA_LAYERS, HY_SHORT, 3 * D), HY_SHORT ** -0.5),
        "hy_conv_b": nrm(ks[17], (N_HYENA_LAYERS, 3 * D), 0.02),
        "hy_f_w1": nrm(ks[18], (N_HYENA_LAYERS, HY_EMB, HY_FILTER_W), HY_EMB ** -0.5),
        "hy_f_b1": nrm(ks[19], (N_HYENA_LAYERS, HY_FILTER_W), 0.1),
        "hy_f_freq1": 1.0 + nrm(ks[20], (N_HYENA_LAYERS, HY_FILTER_W), 0.05),
        "hy_f_w2": nrm(ks[21], (N_HYENA_LAYERS, HY_FILTER_W, HY_FILTER_W), HY_FILTER_W ** -0.5),
        "hy_f_b2": nrm(ks[22], (N_HYENA_LAYERS, HY_FILTER_W), 0.1),
        "hy_f_freq2": 1.0 + nrm(ks[23], (N_HYENA_LAYERS, HY_FILTER_W), 0.05),
        "hy_f_w3": nrm(ks[24], (N_HYENA_LAYERS, HY_FILTER_W, hd), 0.1 * HY_FILTER_W ** -0.5),
        "hy_f_b3": nrm(ks[25], (N_HYENA_LAYERS, hd), 0.01),
        "hy_bias": nrm(ks[26], (N_HYENA_LAYERS, HY_ORDER, D), 0.1),
        "hy_w_out": nrm(ks[27], (N_HYENA_LAYERS, D, D), BETA * D ** -0.5),
    }


def reference(x_prompt, x_sample, cache_k, cache_v, c, c_ctx, mod_w, mod_b, ln_g, ln_b, ffn_w_in, ffn_w_out,
              attn_w_qkv, attn_w_o, attn_rpb, hy_w_in, hy_conv_w, hy_conv_b, hy_f_w1, hy_f_b1, hy_f_freq1,
              hy_f_w2, hy_f_b2, hy_f_freq2, hy_f_w3, hy_f_b3, hy_bias, hy_w_out):
    hy_params = (hy_w_in, hy_conv_w, hy_conv_b, hy_f_w1, hy_f_b1, hy_f_freq1, hy_f_w2, hy_f_b2, hy_f_freq2,
                 hy_f_w3, hy_f_b3, hy_bias, hy_w_out)

    cond_ctx = c_ctx[None, None, :]
    y_prompt = x_prompt
    k_new, v_new = [], []
    for i in range(DEPTH):
        j = i // N_MIXERS
        if i % N_MIXERS == 0:
            def mixer(h, j=j):
                out, k_c, v_c = attention_context(h, attn_w_qkv[j], attn_w_o[j])
                return out, (k_c, v_c)
        else:
            def mixer(h, j=j):
                return hyena(h, *[p[j] for p in hy_params]), ()
        y_prompt, extras = trunk_layer(y_prompt, cond_ctx, mod_w[i], mod_b[i], ln_g[i], ln_b[i],
                                       ffn_w_in[i], ffn_w_out[i], mixer)
        if i % N_MIXERS == 0:
            k_new.append(extras[0])
            v_new.append(extras[1])
    new_cache_k = jnp.stack(k_new, axis=1)
    new_cache_v = jnp.stack(v_new, axis=1)

    cond_lat = c[:, None, :]
    y_sample = x_sample
    for i in range(DEPTH):
        j = i // N_MIXERS
        if i % N_MIXERS == 0:
            def mixer(h, j=j):
                return attention_latent(h, cache_k[:, j], cache_v[:, j], attn_w_qkv[j], attn_w_o[j],
                                        attn_rpb[j]), ()
        else:
            def mixer(h, j=j):
                return hyena(h, *[p[j] for p in hy_params]), ()
        y_sample, _ = trunk_layer(y_sample, cond_lat, mod_w[i], mod_b[i], ln_g[i], ln_b[i],
                                  ffn_w_in[i], ffn_w_out[i], mixer)

    return (y_prompt, y_sample, new_cache_k, new_cache_v)
```

```cpp
#include <hip/hip_runtime.h>
#include <hip/hip_cooperative_groups.h>
#include <cstdio>
#include <cstdint>
namespace cg = cooperative_groups;
#ifndef MK_LAUNCHES
#define MK_LAUNCHES 1
#endif
namespace pg8 {
#define PG8_LAS __attribute__((address_space(3)))
typedef unsigned short bf16_t;
typedef short bf16x8 __attribute__((ext_vector_type(8)));
typedef float f32x4 __attribute__((ext_vector_type(4)));
typedef unsigned u32x4 __attribute__((ext_vector_type(4)));
constexpr int BM = 256, BK = 64, HALF = 128, HTB = HALF * BK * 2  , STAGE_BYTES = 8 * HTB, NXCD = 8, WGM = 8;

__host__ __device__ __forceinline__ int lds_byte(int r, int c) { const int st = (r >> 4) * 2 + (c >> 5), rr = r & 15, cc = c & 31, ob = rr * 64 + cc * 2; return st * 1024 + (ob ^ (((ob >> 9) & 1) << 5)); }
__host__ __device__ __forceinline__ void stage_rc(int b, int& R, int& C) { const int st = b / 1024, sb = b % 1024, swz = sb ^ (((sb >> 9) & 1) << 5); R = (st >> 1) * 16 + swz / 64; C = (st & 1) * 32 + (swz % 64) / 2; }
__host__ __device__ __forceinline__ int perm32(int rho) { const int n = rho >> 4, i = rho & 15; return 8 * (i >> 2) + 4 * n + (i & 3); }

struct Unit { int pm, pn; };
struct Gemm { const bf16_t* A; const bf16_t* Bt; int M, N, K; };

struct StaticOrder {
    int nM, nN, nwg, G, c;
    __host__ __device__ void init(int M, int N, int G_, int c_) { nM = M / BM; nN = N / BM; nwg = nM * nN; G = G_; c = c_; }
    __host__ __device__ bool next(int i, Unit& u) const {
        const long L = (long)i * G + c; if (L >= nwg) return false;
        int wgid = (int)L; { const int q = nwg / NXCD, r = nwg % NXCD, xcd = wgid % NXCD, off = wgid / NXCD; wgid = (xcd < r ? xcd * (q + 1) : r * (q + 1) + (xcd - r) * q) + off; }
        const int nig = WGM * nN, gid = wgid / nig, fm = gid * WGM, gsz = (nM - fm) < WGM ? (nM - fm) : WGM;
        u.pm = fm + ((wgid % nig) % gsz); u.pn = (wgid % nig) / gsz; return true;
    }
    __device__ __forceinline__ void a_ready(const Unit&) const {}
    __device__ __forceinline__ void done(const Unit&) const {}
};
__device__ __forceinline__ unsigned cvt_pk_bf16(float lo, float hi) { unsigned r; asm volatile("v_cvt_pk_bf16_f32 %0, %1, %2" : "=v"(r) : "v"(lo), "v"(hi)); return r; }
typedef float f32x2 __attribute__((ext_vector_type(2)));
template <class Epi, class Sched, bool STAMP = false>
__device__ __forceinline__ void gemm_phase(PG8_LAS unsigned char* lds, const Gemm g, const Sched& S, const Epi& E, unsigned long long* stamps) {
    const int tid = threadIdx.x, wid = __builtin_amdgcn_readfirstlane(tid >> 6), lane = tid & 63, wr = wid >> 2, wc = wid & 3, fr = lane & 15, fq = lane >> 4;
    const int K = g.K, nt = K / BK;
    int ts_lo = 0, ts_hi = 0, nts = 0; const unsigned long long rt_entry = STAMP ? (unsigned long long)wall_clock64() : 0ull;
#define PG8_STAMP() do { if (STAMP && wid == 0 && nts < 64) { const unsigned long long _c = (unsigned long long)clock64(); \
        ts_lo = (lane == nts) ? (int)(unsigned)_c : ts_lo; ts_hi = (lane == nts) ? (int)(unsigned)(_c >> 32) : ts_hi; ++nts; } } while (0)
    PG8_STAMP();
    unsigned voffA[2], voffB[2];
#pragma unroll
    for (int i = 0; i < 2; ++i) { int R, C; stage_rc(tid * 16 + i * 8192, R, C); const int Rb = Epi::PERM ? ((R & ~31) + perm32(R & 31)) : R;
        voffA[i] = (unsigned)(R * K + C) * 2u; voffB[i] = (unsigned)(Rb * K + C) * 2u; }
    const size_t kstep = (size_t)(BK * 2);
    const size_t hstep = (size_t)HALF * K * 2;
    const size_t tstep = 2 * hstep;
    const unsigned ldsw = (unsigned)wid * 1024u;
    const int aoff = lds_byte(wr * 64 + fr, fq * 8), boff = lds_byte(wc * 32 + fr, fq * 8);
#define PG8_SA(b, h) (((b) * 2 + (h)) * HTB)
#define PG8_SB(b, h) ((4 + (b) * 2 + (h)) * HTB)
#define PG8_STAGE(bufoff, gbase, voff) do { _Pragma("unroll") for (int _i = 0; _i < 2; ++_i) \
        __builtin_amdgcn_global_load_lds((const unsigned*)((const char*)(gbase) + (voff)[_i]), (PG8_LAS unsigned*)(lds + (bufoff) + ldsw + _i * 8192), 16, 0, 0); } while (0)
#define PG8_LDA(dst, b, h) do { _Pragma("unroll") for (int m = 0; m < 4; ++m) _Pragma("unroll") for (int k = 0; k < 2; ++k) dst[m][k] = *(const PG8_LAS bf16x8*)(lds + PG8_SA(b, h) + aoff + m * 2048 + k * 1024); } while (0)
#define PG8_LDB(dst, b, h) do { _Pragma("unroll") for (int n = 0; n < 2; ++n) _Pragma("unroll") for (int k = 0; k < 2; ++k) dst[n][k] = *(const PG8_LAS bf16x8*)(lds + PG8_SB(b, h) + boff + n * 2048 + k * 1024); } while (0)
#define PG8_MMA(ai, bj, At, Bt) do { __builtin_amdgcn_s_setprio(1); _Pragma("unroll") for (int m = 0; m < 4; ++m) _Pragma("unroll") for (int n = 0; n < 2; ++n) _Pragma("unroll") for (int k = 0; k < 2; ++k) \
        acc[ai][bj][m][n] = __builtin_amdgcn_mfma_f32_16x16x32_bf16(Bt[n][k], At[m][k], acc[ai][bj][m][n], 0, 0, 0); __builtin_amdgcn_s_setprio(0); } while (0)
#define PG8_WAIT_V(n) asm volatile("s_waitcnt vmcnt(" #n ")" ::: "memory")
#define PG8_WAIT_L(n) asm volatile("s_waitcnt lgkmcnt(" #n ")" ::: "memory")
#define PG8_BAR __builtin_amdgcn_s_barrier()
#define PG8_SCHED __builtin_amdgcn_sched_barrier(0)
    Unit cur, nxt; int ui = 0;
    if (!S.next(0, cur)) return;
    f32x4 acc[2][2][4][2];
#pragma unroll
    for (int a = 0; a < 2; ++a)
#pragma unroll
        for (int b = 0; b < 2; ++b)
#pragma unroll
            for (int m = 0; m < 4; ++m)
#pragma unroll
                for (int n = 0; n < 2; ++n) acc[a][b][m][n] = (f32x4){0.f, 0.f, 0.f, 0.f};
    bf16x8 At[4][2], B0[2][2], B1[2][2];
    const char* cA = (const char*)g.A + (size_t)cur.pm * tstep; const char* cB = (const char*)g.Bt + (size_t)cur.pn * tstep;
    S.a_ready(cur);
    PG8_STAGE(PG8_SB(0, 0), cB, voffB); PG8_STAGE(PG8_SA(0, 0), cA, voffA); PG8_STAGE(PG8_SB(0, 1), cB + hstep, voffB); PG8_STAGE(PG8_SA(0, 1), cA + hstep, voffA);
    if (wr == 1) PG8_BAR;
    PG8_WAIT_V(4); PG8_BAR;
    PG8_STAGE(PG8_SB(1, 0), cB + kstep, voffB); PG8_STAGE(PG8_SA(1, 0), cA + kstep, voffA); PG8_STAGE(PG8_SB(1, 1), cB + hstep + kstep, voffB);
    PG8_WAIT_V(6); PG8_BAR;
    PG8_STAMP();
    for (;;) {
        const bool has_next = S.next(ui + 1, nxt);
        const char* nA = has_next ? (const char*)g.A + (size_t)nxt.pm * tstep : cA; const char* nB = has_next ? (const char*)g.Bt + (size_t)nxt.pn * tstep : cB;
        for (int t = 0; t < nt; t += 2) {
            const bool last = (t == nt - 2);
            const char* a1 = cA + (size_t)(t + 1) * kstep;
            const char* a2 = last ? nA : cA + (size_t)(t + 2) * kstep; const char* b2 = last ? nB : cB + (size_t)(t + 2) * kstep;
            const char* a3 = a2 + kstep; const char* b3 = b2 + kstep;
            if (last && has_next) S.a_ready(nxt);
            PG8_LDB(B0, 0, 0); PG8_SCHED; PG8_LDA(At, 0, 0); PG8_STAGE(PG8_SA(1, 1), a1 + hstep, voffA);
            PG8_WAIT_L(8); PG8_BAR; PG8_WAIT_L(0); PG8_MMA(0, 0, At, B0); PG8_BAR; PG8_SCHED;
            PG8_LDB(B1, 0, 1); PG8_STAGE(PG8_SB(0, 0), b2, voffB);
            PG8_BAR; PG8_WAIT_L(0); PG8_MMA(0, 1, At, B1); PG8_BAR;
            PG8_LDA(At, 0, 1); PG8_STAGE(PG8_SA(0, 0), a2, voffA);
            PG8_BAR; PG8_WAIT_L(0); PG8_MMA(1, 0, At, B0); PG8_BAR; PG8_SCHED;
            PG8_STAGE(PG8_SB(0, 1), b2 + hstep, voffB);
            PG8_WAIT_V(6); PG8_BAR; PG8_MMA(1, 1, At, B1); PG8_BAR;
            PG8_LDB(B0, 1, 0); PG8_SCHED; PG8_LDA(At, 1, 0); PG8_STAGE(PG8_SA(0, 1), a2 + hstep, voffA);
            PG8_WAIT_L(8); PG8_BAR; PG8_WAIT_L(0); PG8_MMA(0, 0, At, B0); PG8_BAR; PG8_SCHED;
            PG8_LDB(B1, 1, 1); PG8_STAGE(PG8_SB(1, 0), b3, voffB);
            PG8_BAR; PG8_WAIT_L(0); PG8_MMA(0, 1, At, B1); PG8_BAR;
            PG8_LDA(At, 1, 1); PG8_STAGE(PG8_SA(1, 0), a3, voffA);
            PG8_BAR; PG8_WAIT_L(0); PG8_MMA(1, 0, At, B0); PG8_BAR; PG8_SCHED;
            PG8_STAGE(PG8_SB(1, 1), b3 + hstep, voffB);
            PG8_WAIT_V(6); PG8_BAR; PG8_MMA(1, 1, At, B1); PG8_BAR;
        }
        PG8_STAMP();
        if constexpr (!Epi::AFTER_DRAIN) { E(acc, cur, wr, wc, fr, fq); S.done(cur); }
        PG8_STAMP();
        if (!has_next) break;
#pragma unroll
        for (int a = 0; a < 2; ++a)
#pragma unroll
            for (int b = 0; b < 2; ++b)
#pragma unroll
                for (int m = 0; m < 4; ++m)
#pragma unroll
                    for (int n = 0; n < 2; ++n) acc[a][b][m][n] = (f32x4){0.f, 0.f, 0.f, 0.f};
        cur = nxt; cA = nA; cB = nB; ++ui;
    }
    PG8_WAIT_V(0);
    if (wr == 0) PG8_BAR;
    PG8_BAR;
    if constexpr (Epi::AFTER_DRAIN) { E.fused(acc, cur, wr, wc, fr, fq, lds, wid, lane); S.done(cur); }
    PG8_STAMP();
    if (STAMP && wid == 0) { stamps[lane] = lane < nts ? (((unsigned long long)(unsigned)ts_hi << 32) | (unsigned)ts_lo) : 0ull;
        if (lane == 62) stamps[62] = rt_entry; if (lane == 63) stamps[63] = (unsigned long long)wall_clock64(); }
#undef PG8_STAMP
#undef PG8_SA
#undef PG8_SB
#undef PG8_STAGE
#undef PG8_LDA
#undef PG8_LDB
#undef PG8_MMA
#undef PG8_WAIT_V
#undef PG8_WAIT_L
#undef PG8_BAR
#undef PG8_SCHED
}
}
using pg8::bf16_t; using pg8::bf16x8; using pg8::f32x4; using pg8::u32x4; using pg8::cvt_pk_bf16; using pg8::Unit;
#define LAS __attribute__((address_space(3)))
typedef float f32x16 __attribute__((ext_vector_type(16)));
typedef unsigned u32x2 __attribute__((ext_vector_type(2)));

constexpr int D = 1024, DFF = 2816, NTOK = 12288, NCTX = 8192;
constexpr float ALPHA = 1.4142135623730951f;
constexpr float LN_EPS = 1e-5f;
constexpr int GS_LAT = 2 * 2048 + 32, GS_CTX = 2 * 256 + 32;

constexpr size_t SZ_WFI = (size_t)5632 * 1024 * 2, SZ_WFO = (size_t)1024 * 2816 * 2;
constexpr size_t WS_WFI = 0;
constexpr size_t WS_WFO = WS_WFI + 4 * SZ_WFI;
constexpr size_t WS_WQKV = WS_WFO + 4 * SZ_WFO;
constexpr size_t WS_WO = WS_WQKV + (size_t)3072 * 1024 * 2;
constexpr size_t WS_WHI = WS_WO + (size_t)1024 * 1024 * 2;
constexpr size_t WS_WHO = WS_WHI + (size_t)3072 * 1024 * 2;
constexpr size_t WS_MOD = WS_WHO + (size_t)1024 * 1024 * 2;
constexpr size_t WS_HID = WS_MOD + (size_t)2 * 3 * 9216 * 4;
constexpr size_t WS_KC = WS_HID + (size_t)(2048 + 256) * 64 * 4;
constexpr size_t WS_VCT = WS_KC + (size_t)2 * 256 * 1024 * 2;
constexpr size_t WS_GLAT = WS_VCT + (size_t)2 * 256 * 1024 * 2;
constexpr size_t WS_GCTX = WS_GLAT + (size_t)2 * 1024 * GS_LAT * 2;
constexpr size_t WS_X = WS_GCTX + (size_t)2 * 1024 * GS_CTX * 2;
constexpr size_t WS_Y = WS_X + (size_t)NTOK * D * 4;
constexpr size_t WS_H = WS_Y + (size_t)NTOK * D * 4;
constexpr size_t WS_M = WS_H + (size_t)NTOK * D * 2;
constexpr size_t WS_ACT = WS_M;
constexpr size_t WS_Q = WS_M;
constexpr size_t WS_K = WS_Q + (size_t)NTOK * D * 2;
constexpr size_t WS_VT = WS_K + (size_t)NTOK * D * 2;
constexpr size_t WS_UT = WS_M;
constexpr size_t WS_O = WS_M + (size_t)NTOK * 3072 * 2;
constexpr size_t WS_END = WS_O + (size_t)NTOK * D * 2;
constexpr int LDS_BYTES = 81920 + 8 * 8256;

struct Params { const float* in[28]; float* out; unsigned char* ws; int ph_lo, ph_hi; };

__device__ __forceinline__ float bf2f(bf16_t b) { return __uint_as_float(((unsigned)b) << 16); }
__device__ __forceinline__ float bflo(unsigned w) { return __uint_as_float(w << 16); }
__device__ __forceinline__ float bfhi(unsigned w) { return __uint_as_float(w & 0xffff0000u); }
__device__ __forceinline__ bf16_t f2bf(float f) { return (bf16_t)(cvt_pk_bf16(f, 0.f) & 0xffffu); }
__device__ __forceinline__ float silu_f(float g) { return g * __builtin_amdgcn_rcpf(1.0f + __expf(-g)); }
__device__ __forceinline__ bf16x8 as_bf16x8(u32x4 v) { union { u32x4 u; bf16x8 b; } x; x.u = v; return x.b; }

struct EpiSwiglu {
    static constexpr bool PERM = true, AFTER_DRAIN = false;
    bf16_t* O;
    __device__ __forceinline__ void operator()(const f32x4 (&acc)[2][2][4][2], const Unit& u, int wr, int wc, int fr, int fq) const {
        const int row0 = u.pm * 256 + wr * 64 + fr, col0 = u.pn * 128 + wc * 32 + 8 * fq;
#pragma unroll
        for (int ai = 0; ai < 2; ++ai)
#pragma unroll
            for (int m = 0; m < 4; ++m) {
                bf16_t* rowp = O + (size_t)(row0 + ai * 128 + m * 16) * DFF + col0;
                const f32x4 g0 = acc[ai][0][m][0], g1 = acc[ai][0][m][1], u0 = acc[ai][1][m][0], u1 = acc[ai][1][m][1];
                u32x4 w;
                w.x = cvt_pk_bf16(silu_f(g0[0]) * u0[0], silu_f(g0[1]) * u0[1]); w.y = cvt_pk_bf16(silu_f(g0[2]) * u0[2], silu_f(g0[3]) * u0[3]);
                w.z = cvt_pk_bf16(silu_f(g1[0]) * u1[0], silu_f(g1[1]) * u1[1]); w.w = cvt_pk_bf16(silu_f(g1[2]) * u1[2], silu_f(g1[3]) * u1[3]);
                *(u32x4*)rowp = w;
            }
    }
};
struct EpiResid {
    static constexpr bool PERM = false, AFTER_DRAIN = false;
    const float* xa; const float* xb; float* Y; const float* modl; int gidx; float gscale;
    __device__ __forceinline__ void operator()(const f32x4 (&acc)[2][2][4][2], const Unit& u, int wr, int wc, int fr, int fq) const {
        const int row0 = u.pm * 256 + wr * 64 + fr, col0 = u.pn * 256 + wc * 32 + 4 * fq;
        const int ci = u.pm < 32 ? 0 : (u.pm < 40 ? 1 : 2);
        const float* gate = modl + ci * 9216 + gidx * 1024 + col0;
        f32x4 gv[2][2];
#pragma unroll
        for (int bj = 0; bj < 2; ++bj)
#pragma unroll
            for (int n = 0; n < 2; ++n) gv[bj][n] = *(const f32x4*)(gate + bj * 128 + n * 16) * gscale;
#pragma unroll
        for (int ai = 0; ai < 2; ++ai)
#pragma unroll
            for (int m = 0; m < 4; ++m) {
                const int row = row0 + ai * 128 + m * 16;
                const float* xr = (row < NCTX ? xa + (size_t)row * D : xb + (size_t)(row - NCTX) * D) + col0;
                float* yr = Y + (size_t)row * D + col0;
#pragma unroll
                for (int bj = 0; bj < 2; ++bj)
#pragma unroll
                    for (int n = 0; n < 2; ++n) { const f32x4 xv = *(const f32x4*)(xr + bj * 128 + n * 16); *(f32x4*)(yr + bj * 128 + n * 16) = xv * ALPHA + gv[bj][n] * acc[ai][bj][m][n]; }
            }
    }
};
__device__ __forceinline__ void store_T(const f32x4 (&acc)[2][2][4][2], const Unit& u, int wr, int wc, int fr, int fq, bf16_t* T, int C, int colt) {
    const bool lat = u.pm >= 32;
    const int L = lat ? 2048 : 256;
    const int row0 = u.pm * 256 + wr * 64 + fr;
#pragma unroll
    for (int ai = 0; ai < 2; ++ai)
#pragma unroll
        for (int m = 0; m < 4; ++m) {
            const int row = row0 + ai * 128 + m * 16;
            const int rr = lat ? row - NCTX : row;
            const int seq = lat ? (rr >> 11) : (rr >> 8), t = lat ? (rr & 2047) : (rr & 255);
            bf16_t* base = T + (lat ? (size_t)NCTX * C : (size_t)0) + (size_t)seq * C * L + t;
#pragma unroll
            for (int bj = 0; bj < 2; ++bj)
#pragma unroll
                for (int n = 0; n < 2; ++n)
#pragma unroll
                    for (int j = 0; j < 4; ++j) { const int col = colt + bj * 128 + wc * 32 + 8 * fq + 4 * n + j; base[(size_t)col * L] = f2bf(acc[ai][bj][m][n][j]); }
        }
}
struct EpiQKV {
    static constexpr bool PERM = true, AFTER_DRAIN = false;
    bf16_t* Q; bf16_t* Kb; bf16_t* Vt; float* outk; float* outv;
    __device__ __forceinline__ void operator()(const f32x4 (&acc)[2][2][4][2], const Unit& u, int wr, int wc, int fr, int fq) const {
        const int sel = u.pn >> 2, colt = (u.pn & 3) * 256;
        const int row0 = u.pm * 256 + wr * 64 + fr, col0 = colt + wc * 32 + 8 * fq;
        if (sel == 2) store_T(acc, u, wr, wc, fr, fq, Vt, 1024, colt);
#pragma unroll
        for (int ai = 0; ai < 2; ++ai)
#pragma unroll
            for (int m = 0; m < 4; ++m) {
                const int row = row0 + ai * 128 + m * 16;
#pragma unroll
                for (int bj = 0; bj < 2; ++bj) {
                    const f32x4 v0 = acc[ai][bj][m][0], v1 = acc[ai][bj][m][1];
                    const size_t off = (size_t)row * D + col0 + bj * 128;
                    if (sel == 0) { u32x4 w; w.x = cvt_pk_bf16(v0[0] * 0.125f, v0[1] * 0.125f); w.y = cvt_pk_bf16(v0[2] * 0.125f, v0[3] * 0.125f); w.z = cvt_pk_bf16(v1[0] * 0.125f, v1[1] * 0.125f); w.w = cvt_pk_bf16(v1[2] * 0.125f, v1[3] * 0.125f); *(u32x4*)(Q + off) = w; }
                    else if (sel == 1) { u32x4 w; w.x = cvt_pk_bf16(v0[0], v0[1]); w.y = cvt_pk_bf16(v0[2], v0[3]); w.z = cvt_pk_bf16(v1[0], v1[1]); w.w = cvt_pk_bf16(v1[2], v1[3]); *(u32x4*)(Kb + off) = w;
                        if (row < NCTX) { *(f32x4*)(outk + off) = v0; *(f32x4*)(outk + off + 4) = v1; } }
                    else { if (row < NCTX) { *(f32x4*)(outv + off) = v0; *(f32x4*)(outv + off + 4) = v1; } }
                }
            }
    }
};
struct EpiHyIn {
    static constexpr bool PERM = true, AFTER_DRAIN = false;
    bf16_t* Ut;
    __device__ __forceinline__ void operator()(const f32x4 (&acc)[2][2][4][2], const Unit& u, int wr, int wc, int fr, int fq) const {
        store_T(acc, u, wr, wc, fr, fq, Ut, 3072, u.pn * 256);
    }
};

template <class Epi>
__device__ __forceinline__ void run_gemm(unsigned char* shm, const bf16_t* A, const bf16_t* Bt, int N, int K, const Epi& E) {
    pg8::Gemm g; g.A = A; g.Bt = Bt; g.M = NTOK; g.N = N; g.K = K;
    pg8::StaticOrder S; S.init(NTOK, N, (int)gridDim.x, (int)blockIdx.x);
    pg8::gemm_phase<Epi, pg8::StaticOrder, false>((PG8_LAS unsigned char*)shm, g, S, E, nullptr);
}

__device__ __forceinline__ void mod_item(const Params& p, int r, unsigned char* shm) {
    const int tid = threadIdx.x;
    const int l = r / 72, n0 = (r % 72) * 128;
    float* sc = (float*)shm;
    float* red = (float*)(shm + 12288);
    for (int i = tid; i < 3072; i += 512) { const int ci = i >> 10, k = i & 1023; const float v = ci == 0 ? p.in[5][k] : p.in[4][(ci - 1) * 1024 + k]; sc[i] = v / (1.0f + __expf(-v)); }
    __syncthreads();
    const int kg = tid >> 7, nn = tid & 127;
    const float* w = p.in[6] + (size_t)l * 1024 * 9216 + n0 + nn;
    float a0 = 0.f, a1 = 0.f, a2 = 0.f;
#pragma unroll 8
    for (int k = kg * 256; k < kg * 256 + 256; ++k) { const float wv = w[(size_t)k * 9216]; a0 += sc[k] * wv; a1 += sc[1024 + k] * wv; a2 += sc[2048 + k] * wv; }
    red[(kg * 3 + 0) * 128 + nn] = a0; red[(kg * 3 + 1) * 128 + nn] = a1; red[(kg * 3 + 2) * 128 + nn] = a2;
    __syncthreads();
    if (tid < 384) { const int ci = tid >> 7; float s = p.in[7][l * 9216 + n0 + nn];
        for (int g = 0; g < 4; ++g) s += red[(g * 3 + ci) * 128 + nn];
        ((float*)(p.ws + WS_MOD))[(l * 3 + ci) * 9216 + n0 + nn] = s; }
    __syncthreads();
}
__device__ __forceinline__ void hid_item(const Params& p, int r, unsigned char* shm) {
    const int tid = threadIdx.x, pp = tid >> 6, j = tid & 63;
    const bool lat = r < 256;
    const int L = lat ? 2048 : 256;
    const int pos = (lat ? r : r - 256) * 8 + pp;
    float* zf = (float*)shm;
    float* h1 = (float*)(shm + 2048);
    if (j < 33) {
        float v;
        if (j == 0) v = (float)pos / (float)(L - 1);
        else { const int bi = (j - 1) & 15; const float band = 1e-4f + (float)bi * ((15.0f - 1e-4f) / 15.0f);
            const float rev = __builtin_amdgcn_fractf(((float)pos / (float)L) * band);
            v = j <= 16 ? __builtin_amdgcn_cosf(rev) : -__builtin_amdgcn_sinf(rev); }
        zf[pp * 33 + j] = v;
    }
    __syncthreads();
    float a = p.in[19][j];
    for (int i = 0; i < 33; ++i) a += zf[pp * 33 + i] * p.in[18][i * 64 + j];
    a *= p.in[20][j];
    h1[pp * 64 + j] = __builtin_amdgcn_sinf(__builtin_amdgcn_fractf(a * 0.15915494309189535f));
    __syncthreads();
    float b = p.in[22][j];
    for (int i = 0; i < 64; ++i) b += h1[pp * 64 + i] * p.in[21][i * 64 + j];
    b *= p.in[23][j];
    float* hid = (float*)(p.ws + WS_HID) + (lat ? 0 : 2048 * 64);
    hid[pos * 64 + j] = __builtin_amdgcn_sinf(__builtin_amdgcn_fractf(b * 0.15915494309189535f));
    __syncthreads();
}
__device__ __forceinline__ void transpose_item(const Params& p, int r, unsigned char* shm) {
    const int tid = threadIdx.x;
    const float* W; bf16_t* WT; int K, N, perm = 0;
    if (r < 5632) { const int mi = r / 1408; r %= 1408; W = p.in[10] + (size_t)mi * 1024 * 5632; WT = (bf16_t*)(p.ws + WS_WFI + mi * SZ_WFI); K = 1024; N = 5632; perm = 1; }
    else if ((r -= 5632) < 2816) { const int mi = r / 704; r %= 704; W = p.in[11] + (size_t)mi * 2816 * 1024; WT = (bf16_t*)(p.ws + WS_WFO + mi * SZ_WFO); K = 2816; N = 1024; }
    else if ((r -= 2816) < 768) { W = p.in[12]; WT = (bf16_t*)(p.ws + WS_WQKV); K = 1024; N = 3072; }
    else if ((r -= 768) < 256) { W = p.in[13]; WT = (bf16_t*)(p.ws + WS_WO); K = 1024; N = 1024; }
    else if ((r -= 256) < 768) { W = p.in[15]; WT = (bf16_t*)(p.ws + WS_WHI); K = 1024; N = 3072; }
    else { r -= 768; W = p.in[27]; WT = (bf16_t*)(p.ws + WS_WHO); K = 1024; N = 1024; }
    const int ntn = N / 64, k0 = (r / ntn) * 64, n0 = (r % ntn) * 64;
    int nd0 = n0;
    if (perm) { const int hf = n0 >= DFF, nn = hf ? n0 - DFF : n0; nd0 = (nn >> 7) * 256 + hf * 128 + (nn & 127); }
    float* tile = (float*)shm;
#pragma unroll
    for (int i = 0; i < 8; ++i) { const int kk = i * 8 + (tid >> 6), nn = tid & 63; tile[kk * 65 + nn] = W[(size_t)(k0 + kk) * N + n0 + nn]; }
    __syncthreads();
    { const int n = tid >> 3, k8 = (tid & 7) * 8; const float* s = tile + k8 * 65 + n;
        u32x4 o; o.x = cvt_pk_bf16(s[0], s[65]); o.y = cvt_pk_bf16(s[2 * 65], s[3 * 65]); o.z = cvt_pk_bf16(s[4 * 65], s[5 * 65]); o.w = cvt_pk_bf16(s[6 * 65], s[7 * 65]);
        *(u32x4*)(WT + (size_t)(nd0 + n) * K + k0 + k8) = o; }
    __syncthreads();
}
__device__ __forceinline__ void p0_phase(const Params& p, unsigned char* shm) {
    constexpr int N_MOD = 144, N_HID = 288, N_KC = 128, N_VC = 128, N_TR = 10496;
    constexpr int TOTAL = N_MOD + N_HID + N_KC + N_VC + N_TR;
    const int tid = threadIdx.x;
    for (int it = blockIdx.x; it < TOTAL; it += gridDim.x) {
        int r = it;
        if (r < N_MOD) { mod_item(p, r, shm); continue; } r -= N_MOD;
        if (r < N_HID) { hid_item(p, r, shm); continue; } r -= N_HID;
        if (r < N_KC) { const size_t e = ((size_t)r * 512 + tid) * 8; const f32x4 a = *(const f32x4*)(p.in[2] + e), b = *(const f32x4*)(p.in[2] + e + 4);
            u32x4 o; o.x = cvt_pk_bf16(a[0], a[1]); o.y = cvt_pk_bf16(a[2], a[3]); o.z = cvt_pk_bf16(b[0], b[1]); o.w = cvt_pk_bf16(b[2], b[3]);
            *(u32x4*)((bf16_t*)(p.ws + WS_KC) + e) = o; continue; } r -= N_KC;
        if (r < N_VC) { const int g = r * 512 + tid;
            const int t = g & 255, c8 = (g >> 8) & 127, b = g >> 15;
            const float* src = p.in[3] + ((size_t)(b * 256 + t)) * 1024 + c8 * 8;
            const f32x4 a = *(const f32x4*)src, bb = *(const f32x4*)(src + 4);
            bf16_t* dst = (bf16_t*)(p.ws + WS_VCT) + ((size_t)b * 1024 + c8 * 8) * 256 + t;
            dst[0] = f2bf(a[0]); dst[256] = f2bf(a[1]); dst[512] = f2bf(a[2]); dst[768] = f2bf(a[3]);
            dst[1024] = f2bf(bb[0]); dst[1280] = f2bf(bb[1]); dst[1536] = f2bf(bb[2]); dst[1792] = f2bf(bb[3]); continue; } r -= N_VC;
        transpose_item(p, r, shm);
    }
}

__device__ __forceinline__ float wave_sum(float v) {
#pragma unroll
    for (int o = 1; o < 64; o <<= 1) v += __shfl_xor(v, o);
    return v;
}
__device__ __forceinline__ void row_phase(const Params& p, int mode, const float* Ysrc, float* Xout, const float* lng, const float* lnb, const float* modl, int shidx) {
    const int lane = threadIdx.x & 63, gw = blockIdx.x * 8 + (threadIdx.x >> 6), ngw = gridDim.x * 8;
    bf16_t* H = (bf16_t*)(p.ws + WS_H);
    for (int row = gw; row < NTOK; row += ngw) {
        const float* src = mode == 0 ? (row < NCTX ? p.in[0] + (size_t)row * D : p.in[1] + (size_t)(row - NCTX) * D) : Ysrc + (size_t)row * D;
        f32x4 v[4];
#pragma unroll
        for (int j = 0; j < 4; ++j) v[j] = *(const f32x4*)(src + lane * 4 + 256 * j);
        if (mode != 0) {
            float s = 0.f;
#pragma unroll
            for (int j = 0; j < 4; ++j) s += (v[j][0] + v[j][1]) + (v[j][2] + v[j][3]);
            const float mean = wave_sum(s) * (1.0f / D);
            float s2 = 0.f;
#pragma unroll
            for (int j = 0; j < 4; ++j) { v[j] = v[j] - mean; s2 += (v[j][0] * v[j][0] + v[j][1] * v[j][1]) + (v[j][2] * v[j][2] + v[j][3] * v[j][3]); }
            const float rstd = 1.0f / sqrtf(wave_sum(s2) * (1.0f / D) + LN_EPS);
#pragma unroll
            for (int j = 0; j < 4; ++j) { const f32x4 g = *(const f32x4*)(lng + lane * 4 + 256 * j), b = *(const f32x4*)(lnb + lane * 4 + 256 * j);
                v[j] = v[j] * rstd * g + b; *(f32x4*)(Xout + (size_t)row * D + lane * 4 + 256 * j) = v[j]; }
        }
        if (mode != 2) {
            const int ci = row < NCTX ? 0 : (row < NCTX + 2048 ? 1 : 2);
            const float* sh = modl + ci * 9216 + shidx * 1024, *scp = sh + 1024;
#pragma unroll
            for (int j = 0; j < 4; ++j) { const f32x4 a = *(const f32x4*)(sh + lane * 4 + 256 * j), s = *(const f32x4*)(scp + lane * 4 + 256 * j);
                const f32x4 h = v[j] * (s + 1.0f) + a; u32x2 w; w.x = cvt_pk_bf16(h[0], h[1]); w.y = cvt_pk_bf16(h[2], h[3]);
                *(u32x2*)(H + (size_t)row * D + lane * 4 + 256 * j) = w; }
        }
    }
}

__device__ __forceinline__ void gimg_item(const Params& p, int r) {
    const int tid = threadIdx.x;
    const bool lat = r < 2048;
    const int L = lat ? 2048 : 256, GS = 2 * L + 32;
    const int pch = lat ? (r >> 8) : 0, cgp = lat ? (r & 255) : (r - 2048);
    const int pos = pch * 256 + (tid & 255);
    const int o = __builtin_amdgcn_readfirstlane(tid >> 8);
    const float* hid = (const float*)(p.ws + WS_HID) + (lat ? 0 : 2048 * 64) + (size_t)pos * 64;
    float hr[64];
#pragma unroll
    for (int i = 0; i < 16; ++i) { const f32x4 t = *(const f32x4*)(hid + 4 * i); hr[4 * i] = t[0]; hr[4 * i + 1] = t[1]; hr[4 * i + 2] = t[2]; hr[4 * i + 3] = t[3]; }
    const float tt = (float)pos / (float)(L - 1);
    bf16_t* img = (bf16_t*)(p.ws + (lat ? WS_GLAT : WS_GCTX));
    const float* w3 = p.in[24]; const float* b3 = p.in[25]; const float* hb = p.in[26];
    for (int cc = 0; cc < 4; ++cc) {
        const int c = cgp * 4 + cc;
        const float da = -3.0701134573253943f, db = -15.350567286626972f;
        const float delta = fabsf(da + (float)c * ((db - da) / 1023.0f));
        const float decay = __expf(-tt * delta);
        bf16_t* im = img + (size_t)(o * 1024 + c) * GS;
#pragma unroll
        for (int dir = 0; dir < 2; ++dir) {
            const int n = (o * 2 + dir) * 1024 + c;
            float dot = b3[n];
#pragma unroll
            for (int i = 0; i < 64; ++i) dot += hr[i] * w3[i * 4096 + n];
            float val = dot * decay;
            if (dir == 0) { if (pos == 0) val += hb[o * 1024 + c]; im[L - pos] = f2bf(val); }
            else { if (pos != 0) im[L + pos] = f2bf(val); else im[0] = 0; }
        }
        if (pch == 0 && (tid & 255) < 32) im[2 * L + (tid & 255)] = 0;
    }
}
__device__ __forceinline__ void p1_phase(const Params& p) {
    for (int it = blockIdx.x; it < 2048 + 256; it += gridDim.x) gimg_item(p, it);
    row_phase(p, 0, nullptr, nullptr, nullptr, nullptr, (const float*)(p.ws + WS_MOD), 0);
}

struct AttnArgs { const bf16_t *Q, *K, *Vt, *Kc, *Vct; const float* rpb; bf16_t* O; };
template <bool LAT>
__device__ __forceinline__ void attn_wave(const AttnArgs& A, int b, int h, int qrow0, int r, int n, int lane) {
    constexpr int NKB = LAT ? 32 : 16;
    const int fr = lane & 15, fq = lane >> 4;
    const bf16_t* qp = A.Q + (size_t)(qrow0 + fr) * D + h * 64 + 8 * fq;
    const bf16x8 q0 = *(const bf16x8*)qp, q1 = *(const bf16x8*)(qp + 32);
    int rs = 0, kstart = 0;
    if (LAT) { rs = min(max(r - 4, 0), 24); kstart = n == 0 ? 0 : (n == 1 ? 8 : (n == 2 ? 24 : 32)); }
    f32x4 s[NKB];
#pragma unroll
    for (int kb = 0; kb < NKB; ++kb) {
        const bf16_t* kp;
        if (LAT && kb < 16) kp = A.K + (size_t)(NCTX + b * 2048 + (rs + (kb >> 1)) * 64 + kstart + (kb & 1) * 16 + fr) * D;
        else if (LAT) kp = A.Kc + (size_t)(b * 256 + (kb - 16) * 16 + fr) * D;
        else kp = A.K + (size_t)(b * 256 + kb * 16 + fr) * D;
        kp += h * 64 + 8 * fq;
        const bf16x8 a0 = *(const bf16x8*)kp, a1 = *(const bf16x8*)(kp + 32);
        f32x4 z = {0.f, 0.f, 0.f, 0.f};
        z = __builtin_amdgcn_mfma_f32_16x16x32_bf16(a0, q0, z, 0, 0, 0);
        z = __builtin_amdgcn_mfma_f32_16x16x32_bf16(a1, q1, z, 0, 0, 0);
        s[kb] = z;
    }
    if (LAT) {
        const int qcol = n * 16 + fr, cstart = min(max(qcol - 8, 0), 48);
#pragma unroll
        for (int kb = 0; kb < 16; ++kb) {
            const int drow = rs + (kb >> 1) - r + 7;
            const float* bp = A.rpb + h * 465 + drow * 31;
#pragma unroll
            for (int i = 0; i < 4; ++i) {
                const int kc = kstart + (kb & 1) * 16 + 4 * fq + i;
                const bool ok = kc >= cstart && kc < cstart + 16;
                const int dcol = min(max(kc - qcol, -15), 15) + 15;
                const float bias = bp[dcol];
                s[kb][i] = ok ? s[kb][i] + bias : -INFINITY;
            }
        }
    }
    float mx = -INFINITY;
#pragma unroll
    for (int kb = 0; kb < NKB; ++kb) mx = fmaxf(fmaxf(fmaxf(s[kb][0], s[kb][1]), fmaxf(s[kb][2], s[kb][3])), mx);
    mx = fmaxf(mx, __shfl_xor(mx, 16)); mx = fmaxf(mx, __shfl_xor(mx, 32));
    float sum = 0.f;
#pragma unroll
    for (int kb = 0; kb < NKB; ++kb)
#pragma unroll
        for (int i = 0; i < 4; ++i) { const float e = __expf(s[kb][i] - mx); s[kb][i] = e; sum += e; }
    sum += __shfl_xor(sum, 16); sum += __shfl_xor(sum, 32);
    const float inv = 1.0f / sum;
    f32x4 o[4];
#pragma unroll
    for (int db = 0; db < 4; ++db) o[db] = (f32x4){0.f, 0.f, 0.f, 0.f};
#pragma unroll
    for (int pp = 0; pp < NKB / 2; ++pp) {
        u32x4 pw; pw.x = cvt_pk_bf16(s[2 * pp][0], s[2 * pp][1]); pw.y = cvt_pk_bf16(s[2 * pp][2], s[2 * pp][3]);
        pw.z = cvt_pk_bf16(s[2 * pp + 1][0], s[2 * pp + 1][1]); pw.w = cvt_pk_bf16(s[2 * pp + 1][2], s[2 * pp + 1][3]);
        const bf16x8 pf = as_bf16x8(pw);
#pragma unroll
        for (int db = 0; db < 4; ++db) {
            const int col = h * 64 + 16 * db + fr;
            const bf16_t* vp;
            if (LAT && pp < 8) vp = A.Vt + (size_t)NCTX * 1024 + (size_t)b * (1024 * 2048) + (size_t)col * 2048 + (rs + pp) * 64 + kstart + 4 * fq;
            else if (LAT) vp = A.Vct + (size_t)b * (1024 * 256) + col * 256 + (pp - 8) * 32 + 4 * fq;
            else vp = A.Vt + (size_t)b * (1024 * 256) + col * 256 + pp * 32 + 4 * fq;
            const u32x2 v0 = *(const u32x2*)vp, v1 = *(const u32x2*)(vp + 16);
            u32x4 vw; vw.x = v0.x; vw.y = v0.y; vw.z = v1.x; vw.w = v1.y;
            o[db] = __builtin_amdgcn_mfma_f32_16x16x32_bf16(as_bf16x8(vw), pf, o[db], 0, 0, 0);
        }
    }
    bf16_t* op = A.O + (size_t)(qrow0 + fr) * D + h * 64 + 4 * fq;
#pragma unroll
    for (int db = 0; db < 4; ++db) { u32x2 w; w.x = cvt_pk_bf16(o[db][0] * inv, o[db][1] * inv); w.y = cvt_pk_bf16(o[db][2] * inv, o[db][3] * inv); *(u32x2*)(op + 16 * db) = w; }
}
__device__ __forceinline__ void attn_phase(const Params& p) {
    AttnArgs A; A.Q = (const bf16_t*)(p.ws + WS_Q); A.K = (const bf16_t*)(p.ws + WS_K); A.Vt = (const bf16_t*)(p.ws + WS_VT);
    A.Kc = (const bf16_t*)(p.ws + WS_KC); A.Vct = (const bf16_t*)(p.ws + WS_VCT); A.rpb = p.in[14]; A.O = (bf16_t*)(p.ws + WS_O);
    const int w = threadIdx.x >> 6, lane = threadIdx.x & 63;
    for (int it = blockIdx.x; it < 512 + 1024; it += gridDim.x) {
        if (it < 512) { const int b = it >> 8, r = (it >> 3) & 31, h = (it & 7) * 2 + (w >> 2), n = w & 3;
            attn_wave<true>(A, b, h, NCTX + b * 2048 + r * 64 + n * 16, r, n, lane); }
        else { const int i2 = it - 512; const int b = i2 >> 5, h = (i2 >> 1) & 15, qc = (i2 & 1) * 8 + w;
            attn_wave<false>(A, b, h, b * 256 + qc * 16, 0, 0, lane); }
    }
}

__device__ __forceinline__ void hyena_item(const Params& p, int item, LAS unsigned char* lds) {
    const int tid = threadIdx.x, wid = tid >> 6, lane = tid & 63, a = lane & 31, hh = lane >> 5;
    const bool lat = item < 128;
    const int L = lat ? 2048 : 256, lognb = lat ? 6 : 3, nb = 1 << lognb;
    const int cgp = lat ? item : ((item - 128) >> 1), seq0 = lat ? 0 : ((item - 128) & 1) * 16;
    const int c = cgp * 8 + wid;
    const bf16_t* ut = (const bf16_t*)(p.ws + WS_UT) + (lat ? (size_t)NCTX * 3072 : (size_t)0);
    const size_t sstr = (size_t)3072 * L;
    const int GS = 2 * L + 32;
    const bf16_t* gim = (const bf16_t*)(p.ws + (lat ? WS_GLAT : WS_GCTX));
    LAS unsigned char* zb = lds + wid * 10240;
    LAS unsigned char* gb = lds + 81920 + wid * 8256;
    const float* cw = p.in[16]; const float* cb = p.in[17];
    {
        const float w0 = cw[c], w1 = cw[3072 + c], w2 = cw[6144 + c], bb = cb[c];
        for (int it8 = 0; it8 < 8; ++it8) {
            const int ch = it8 * 64 + lane, col = ch >> 2, part = ch & 3, bl = col >> lognb, i = col & (nb - 1), t0 = 32 * i + 8 * part;
            const bf16_t* ptr = ut + (size_t)(seq0 + bl) * sstr + (size_t)c * L + t0;
            const u32x4 mv = *(const u32x4*)ptr;
            float e[10];
            e[0] = t0 > 0 ? bf2f(ptr[-1]) : 0.f; e[9] = (t0 + 8 < L) ? bf2f(ptr[8]) : 0.f;
            e[1] = bflo(mv.x); e[2] = bfhi(mv.x); e[3] = bflo(mv.y); e[4] = bfhi(mv.y); e[5] = bflo(mv.z); e[6] = bfhi(mv.z); e[7] = bflo(mv.w); e[8] = bfhi(mv.w);
            float o8[8];
#pragma unroll
            for (int j = 0; j < 8; ++j) o8[j] = w0 * e[j] + w1 * e[j + 1] + w2 * e[j + 2] + bb;
            u32x4 ov; ov.x = cvt_pk_bf16(o8[0], o8[1]); ov.y = cvt_pk_bf16(o8[2], o8[3]); ov.z = cvt_pk_bf16(o8[4], o8[5]); ov.w = cvt_pk_bf16(o8[6], o8[7]);
            *(LAS u32x4*)(zb + col * 80 + part * 16) = ov;
        }
    }
    f32x16 acc[4];
#pragma unroll 1
    for (int o = 0; o < 2; ++o) {
        { const u32x4* src = (const u32x4*)(gim + (size_t)(o * 1024 + c) * GS); const int nch = GS / 8;
            for (int i = lane; i < nch; i += 64) *(LAS u32x4*)(gb + i * 16) = src[i]; }
#pragma unroll
        for (int q = 0; q < 4; ++q)
#pragma unroll
            for (int j = 0; j < 16; ++j) acc[q][j] = 0.f;
        for (int k = -(nb - 1); k <= nb - 1; ++k) {
#pragma unroll
            for (int s = 0; s < 2; ++s) {
                const int i0 = L - 32 * k - a + 16 * s + 8 * hh;
                const LAS unsigned* gw = (const LAS unsigned*)gb + (i0 >> 1);
                const unsigned g0 = gw[0], g1 = gw[1], g2 = gw[2], g3 = gw[3], g4 = gw[4];
                const unsigned sh = (unsigned)(i0 & 1) * 2u;
                u32x4 af; af.x = __builtin_amdgcn_alignbyte(g1, g0, sh); af.y = __builtin_amdgcn_alignbyte(g2, g1, sh); af.z = __builtin_amdgcn_alignbyte(g3, g2, sh); af.w = __builtin_amdgcn_alignbyte(g4, g3, sh);
                const bf16x8 afr = as_bf16x8(af);
#pragma unroll
                for (int q = 0; q < 4; ++q) {
                    const int col = 32 * q + a, src = (col & (nb - 1)) - k;
                    u32x4 bv = {0u, 0u, 0u, 0u};
                    if ((unsigned)src < (unsigned)nb) bv = *(const LAS u32x4*)(zb + (col - k) * 80 + 32 * s + 16 * hh);
                    acc[q] = __builtin_amdgcn_mfma_f32_32x32x16_bf16(afr, as_bf16x8(bv), acc[q], 0, 0, 0);
                }
            }
        }
        const int c3 = (o + 1) * 1024 + c;
        const float w0 = cw[c3], w1 = cw[3072 + c3], w2 = cw[6144 + c3], bb = cb[c3];
        if (o == 1) __syncthreads();
#pragma unroll
        for (int q = 0; q < 4; ++q) {
            const int col = 32 * q + a, bl = col >> lognb, i = col & (nb - 1);
            const bf16_t* base = ut + (size_t)(seq0 + bl) * sstr + (size_t)c3 * L + 32 * i;
#pragma unroll
            for (int rg = 0; rg < 4; ++rg) {
                const int a0 = 8 * rg + 4 * hh, t = 32 * i + a0;
                const u32x2 mv = *(const u32x2*)(base + a0);
                float e[6];
                e[0] = t > 0 ? bf2f(base[a0 - 1]) : 0.f; e[5] = (t + 4 < L) ? bf2f(base[a0 + 4]) : 0.f;
                e[1] = bflo(mv.x); e[2] = bfhi(mv.x); e[3] = bflo(mv.y); e[4] = bfhi(mv.y);
                float z[4];
#pragma unroll
                for (int j = 0; j < 4; ++j) z[j] = acc[q][4 * rg + j] * (w0 * e[j] + w1 * e[j + 1] + w2 * e[j + 2] + bb);
                if (o == 0) { u32x2 w; w.x = cvt_pk_bf16(z[0], z[1]); w.y = cvt_pk_bf16(z[2], z[3]); *(LAS u32x2*)(zb + col * 80 + a0 * 2) = w; }
                else {
                    LAS bf16_t* stg = (LAS bf16_t*)lds;
#pragma unroll
                    for (int j = 0; j < 4; ++j) stg[((a0 + j) * 128 + col) * 8 + wid] = f2bf(z[j]);
                }
            }
        }
    }
    __syncthreads();
    {
        bf16_t* O = (bf16_t*)(p.ws + WS_O);
        for (int idx = tid; idx < 4096; idx += 512) {
            const int tin = idx >> 7, col = idx & 127, bl = col >> lognb, i = col & (nb - 1), sq = seq0 + bl;
            const int tok = (lat ? NCTX + sq * 2048 : sq * 256) + 32 * i + tin;
            *(u32x4*)(O + (size_t)tok * D + cgp * 8) = *(const LAS u32x4*)(lds + idx * 16);
        }
    }
    __syncthreads();
}

constexpr int N_PHASES = 22;
__device__ __forceinline__ void run_phase(const Params& p, int ph, unsigned char* shm) {
    const float* mod = (const float*)(p.ws + WS_MOD);
    float* X = (float*)(p.ws + WS_X); float* Y = (float*)(p.ws + WS_Y);
    const bf16_t* H = (const bf16_t*)(p.ws + WS_H);
    if (ph == 0) { p0_phase(p, shm); return; }
    if (ph == 1) { p1_phase(p); return; }
    const int l = (ph - 2) / 10, sp = (ph - 2) % 10;
    const float* modl = mod + (size_t)l * 3 * 9216;
    if (sp == 0 || sp == 7) {
        const int s = sp == 0 ? 0 : 1;
        EpiSwiglu E; E.O = (bf16_t*)(p.ws + WS_ACT);
        run_gemm(shm, H, (const bf16_t*)(p.ws + WS_WFI + (size_t)(l * 2 + s) * SZ_WFI), 5632, 1024, E);
    } else if (sp == 1 || sp == 8 || sp == 5) {
        EpiResid E; E.Y = Y; E.modl = modl;
        const bool first = (l == 0 && sp == 1);
        E.xa = first ? p.in[0] : X; E.xb = first ? p.in[1] : X + (size_t)NCTX * D;
        const bf16_t* A; const bf16_t* Bt; int K;
        if (sp == 5) { A = (const bf16_t*)(p.ws + WS_O); Bt = (const bf16_t*)(p.ws + (l == 0 ? WS_WO : WS_WHO)); K = 1024; E.gidx = 5; E.gscale = 1.0f; }
        else { const int s = sp == 1 ? 0 : 1; A = (const bf16_t*)(p.ws + WS_ACT); Bt = (const bf16_t*)(p.ws + WS_WFO + (size_t)(l * 2 + s) * SZ_WFO); K = DFF; E.gidx = sp == 1 ? 2 : 8; E.gscale = 0.5f; }
        run_gemm(shm, A, Bt, 1024, K, E);
    } else if (sp == 2 || sp == 6 || sp == 9) {
        const int k = sp == 2 ? 0 : (sp == 6 ? 1 : 2);
        const float* lng = p.in[8] + (size_t)(l * 3 + k) * D; const float* lnb = p.in[9] + (size_t)(l * 3 + k) * D;
        if (sp == 9 && l == 1) row_phase(p, 2, Y, p.out, lng, lnb, modl, 0);
        else if (sp == 9) row_phase(p, 1, Y, X, lng, lnb, modl + 3 * 9216, 0);
        else row_phase(p, 1, Y, X, lng, lnb, modl, sp == 2 ? 3 : 6);
    } else if (sp == 3) {
        if (l == 0) { EpiQKV E; E.Q = (bf16_t*)(p.ws + WS_Q); E.Kb = (bf16_t*)(p.ws + WS_K); E.Vt = (bf16_t*)(p.ws + WS_VT); E.outk = p.out + (size_t)NTOK * D; E.outv = p.out + (size_t)NTOK * D + (size_t)NCTX * D;
            run_gemm(shm, H, (const bf16_t*)(p.ws + WS_WQKV), 3072, 1024, E); }
        else { EpiHyIn E; E.Ut = (bf16_t*)(p.ws + WS_UT); run_gemm(shm, H, (const bf16_t*)(p.ws + WS_WHI), 3072, 1024, E); }
    } else {
        if (l == 0) attn_phase(p);
        else { for (int it = blockIdx.x; it < 128 + 256; it += gridDim.x) hyena_item(p, it, (LAS unsigned char*)shm); }
    }
}

__global__ __launch_bounds__(512, 2) void mega_fwd(Params p) {
    extern __shared__ __attribute__((aligned(16))) unsigned char shm[];
    cg::grid_group grid = cg::this_grid();
#define MK_PHASE(K) if (p.ph_lo <= (K) && (K) < p.ph_hi) { run_phase(p, (K), shm); if ((K) + 1 < p.ph_hi) grid.sync(); }
    MK_PHASE(0) MK_PHASE(1) MK_PHASE(2) MK_PHASE(3) MK_PHASE(4) MK_PHASE(5) MK_PHASE(6) MK_PHASE(7) MK_PHASE(8) MK_PHASE(9) MK_PHASE(10)
    MK_PHASE(11) MK_PHASE(12) MK_PHASE(13) MK_PHASE(14) MK_PHASE(15) MK_PHASE(16) MK_PHASE(17) MK_PHASE(18) MK_PHASE(19) MK_PHASE(20) MK_PHASE(21)
#undef MK_PHASE
}

extern "C" void kernel_launch(void* const* d_in, const int* in_sizes, int n_in, void* d_out, int out_size, void* d_ws, size_t ws_size, hipStream_t stream) {
    static int grid = 0;
    if (grid == 0) {
        if (n_in != 28 || ws_size < WS_END) { fprintf(stderr, "kernel_launch: need 28 inputs and %zu B of workspace (got %d, %zu)\n", (size_t)WS_END, n_in, ws_size); grid = -1; return; }
        int dev = 0, cus = 0, per_cu = 0;
        hipGetDevice(&dev);
        hipDeviceGetAttribute(&cus, hipDeviceAttributeMultiprocessorCount, dev);
        if (hipFuncSetAttribute((const void*)mega_fwd, hipFuncAttributeMaxDynamicSharedMemorySize, LDS_BYTES) != hipSuccess) { fprintf(stderr, "kernel_launch: hipFuncSetAttribute failed\n"); grid = -1; return; }
        hipOccupancyMaxActiveBlocksPerMultiprocessor(&per_cu, (const void*)mega_fwd, 512, LDS_BYTES);
        if (per_cu < 1) { fprintf(stderr, "kernel_launch: occupancy query says %d blocks per CU\n", per_cu); per_cu = 1; }
        (void)hipGetLastError();
        grid = cus;
    }
    if (grid < 0) return;
    Params p{};
    for (int i = 0; i < 28; ++i) p.in[i] = (const float*)d_in[i];
    p.out = (float*)d_out; p.ws = (unsigned char*)d_ws;
#if MK_LAUNCHES == 1
    p.ph_lo = 0; p.ph_hi = N_PHASES;
    void* args[] = {&p};
    hipError_t e = hipLaunchCooperativeKernel((const void*)mega_fwd, dim3(grid), dim3(512), args, LDS_BYTES, stream);
    if (e != hipSuccess) fprintf(stderr, "cooperative launch failed: %s (grid %d)\n", hipGetErrorString(e), grid);
#else
    for (int ph = 0; ph < N_PHASES; ++ph) {
        p.ph_lo = ph; p.ph_hi = ph + 1;
        hipLaunchKernelGGL(mega_fwd, dim3(grid), dim3(512), LDS_BYTES, stream, p);
    }
#endif
}
```

```cpp
#include <hip/hip_runtime.h>
#include <hip/hip_cooperative_groups.h>
#include <cstdio>
#include <cstdint>
namespace cg = cooperative_groups;
#ifndef MK_LAUNCHES
#define MK_LAUNCHES 1
#endif
#ifndef MK_DUP_MASK
#define MK_DUP_MASK 0u
#endif
namespace pg8 {
#define PG8_LAS __attribute__((address_space(3)))
typedef unsigned short bf16_t;
typedef short bf16x8 __attribute__((ext_vector_type(8)));
typedef float f32x4 __attribute__((ext_vector_type(4)));
typedef unsigned u32x4 __attribute__((ext_vector_type(4)));
constexpr int BM = 256, BK = 64, HALF = 128, HTB = HALF * BK * 2  , STAGE_BYTES = 8 * HTB, NXCD = 8, WGM = 8;

__host__ __device__ __forceinline__ int lds_byte(int r, int c) { const int st = (r >> 4) * 2 + (c >> 5), rr = r & 15, cc = c & 31, ob = rr * 64 + cc * 2; return st * 1024 + (ob ^ (((ob >> 9) & 1) << 5)); }
__host__ __device__ __forceinline__ void stage_rc(int b, int& R, int& C) { const int st = b / 1024, sb = b % 1024, swz = sb ^ (((sb >> 9) & 1) << 5); R = (st >> 1) * 16 + swz / 64; C = (st & 1) * 32 + (swz % 64) / 2; }
__host__ __device__ __forceinline__ int perm32(int rho) { const int n = rho >> 4, i = rho & 15; return 8 * (i >> 2) + 4 * n + (i & 3); }

struct Unit { int pm, pn; };
struct Gemm { const bf16_t* A; const bf16_t* Bt; int M, N, K; };

struct StaticOrder {
    int nM, nN, nwg, G, c;
    __host__ __device__ void init(int M, int N, int G_, int c_) { nM = M / BM; nN = N / BM; nwg = nM * nN; G = G_; c = c_; }
    __host__ __device__ bool next(int i, Unit& u) const {
        const long L = (long)i * G + c; if (L >= nwg) return false;
        int wgid = (int)L; { const int q = nwg / NXCD, r = nwg % NXCD, xcd = wgid % NXCD, off = wgid / NXCD; wgid = (xcd < r ? xcd * (q + 1) : r * (q + 1) + (xcd - r) * q) + off; }
        const int nig = WGM * nN, gid = wgid / nig, fm = gid * WGM, gsz = (nM - fm) < WGM ? (nM - fm) : WGM;
        u.pm = fm + ((wgid % nig) % gsz); u.pn = (wgid % nig) / gsz; return true;
    }
    __device__ __forceinline__ void a_ready(const Unit&) const {}
    __device__ __forceinline__ void done(const Unit&) const {}
};
__device__ __forceinline__ unsigned cvt_pk_bf16(float lo, float hi) { unsigned r; asm volatile("v_cvt_pk_bf16_f32 %0, %1, %2" : "=v"(r) : "v"(lo), "v"(hi)); return r; }
typedef float f32x2 __attribute__((ext_vector_type(2)));
template <class Epi, class Sched, bool STAMP = false>
__device__ __forceinline__ void gemm_phase(PG8_LAS unsigned char* lds, const Gemm g, const Sched& S, const Epi& E, unsigned long long* stamps) {
    const int tid = threadIdx.x, wid = __builtin_amdgcn_readfirstlane(tid >> 6), lane = tid & 63, wr = wid >> 2, wc = wid & 3, fr = lane & 15, fq = lane >> 4;
    const int K = g.K, nt = K / BK;
    int ts_lo = 0, ts_hi = 0, nts = 0; const unsigned long long rt_entry = STAMP ? (unsigned long long)wall_clock64() : 0ull;
#define PG8_STAMP() do { if (STAMP && wid == 0 && nts < 64) { const unsigned long long _c = (unsigned long long)clock64(); \
        ts_lo = (lane == nts) ? (int)(unsigned)_c : ts_lo; ts_hi = (lane == nts) ? (int)(unsigned)(_c >> 32) : ts_hi; ++nts; } } while (0)
    PG8_STAMP();
    unsigned voffA[2], voffB[2];
#pragma unroll
    for (int i = 0; i < 2; ++i) { int R, C; stage_rc(tid * 16 + i * 8192, R, C); const int Rb = Epi::PERM ? ((R & ~31) + perm32(R & 31)) : R;
        voffA[i] = (unsigned)(R * K + C) * 2u; voffB[i] = (unsigned)(Rb * K + C) * 2u; }
    const size_t kstep = (size_t)(BK * 2);
    const size_t hstep = (size_t)HALF * K * 2;
    const size_t tstep = 2 * hstep;
    const unsigned ldsw = (unsigned)wid * 1024u;
    const int aoff = lds_byte(wr * 64 + fr, fq * 8), boff = lds_byte(wc * 32 + fr, fq * 8);
#define PG8_SA(b, h) (((b) * 2 + (h)) * HTB)
#define PG8_SB(b, h) ((4 + (b) * 2 + (h)) * HTB)
#define PG8_STAGE(bufoff, gbase, voff) do { _Pragma("unroll") for (int _i = 0; _i < 2; ++_i) \
        __builtin_amdgcn_global_load_lds((const unsigned*)((const char*)(gbase) + (voff)[_i]), (PG8_LAS unsigned*)(lds + (bufoff) + ldsw + _i * 8192), 16, 0, 0); } while (0)
#define PG8_LDA(dst, b, h) do { _Pragma("unroll") for (int m = 0; m < 4; ++m) _Pragma("unroll") for (int k = 0; k < 2; ++k) dst[m][k] = *(const PG8_LAS bf16x8*)(lds + PG8_SA(b, h) + aoff + m * 2048 + k * 1024); } while (0)
#define PG8_LDB(dst, b, h) do { _Pragma("unroll") for (int n = 0; n < 2; ++n) _Pragma("unroll") for (int k = 0; k < 2; ++k) dst[n][k] = *(const PG8_LAS bf16x8*)(lds + PG8_SB(b, h) + boff + n * 2048 + k * 1024); } while (0)
#define PG8_MMA(ai, bj, At, Bt) do { __builtin_amdgcn_s_setprio(1); _Pragma("unroll") for (int m = 0; m < 4; ++m) _Pragma("unroll") for (int n = 0; n < 2; ++n) _Pragma("unroll") for (int k = 0; k < 2; ++k) \
        acc[ai][bj][m][n] = __builtin_amdgcn_mfma_f32_16x16x32_bf16(Bt[n][k], At[m][k], acc[ai][bj][m][n], 0, 0, 0); __builtin_amdgcn_s_setprio(0); } while (0)
#define PG8_WAIT_V(n) asm volatile("s_waitcnt vmcnt(" #n ")" ::: "memory")
#define PG8_WAIT_L(n) asm volatile("s_waitcnt lgkmcnt(" #n ")" ::: "memory")
#define PG8_BAR __builtin_amdgcn_s_barrier()
#define PG8_SCHED __builtin_amdgcn_sched_barrier(0)
    Unit cur, nxt; int ui = 0;
    if (!S.next(0, cur)) return;
    f32x4 acc[2][2][4][2];
#pragma unroll
    for (int a = 0; a < 2; ++a)
#pragma unroll
        for (int b = 0; b < 2; ++b)
#pragma unroll
            for (int m = 0; m < 4; ++m)
#pragma unroll
                for (int n = 0; n < 2; ++n) acc[a][b][m][n] = (f32x4){0.f, 0.f, 0.f, 0.f};
    bf16x8 At[4][2], B0[2][2], B1[2][2];
    const char* cA = (const char*)g.A + (size_t)cur.pm * tstep; const char* cB = (const char*)g.Bt + (size_t)cur.pn * tstep;
    S.a_ready(cur);
    PG8_STAGE(PG8_SB(0, 0), cB, voffB); PG8_STAGE(PG8_SA(0, 0), cA, voffA); PG8_STAGE(PG8_SB(0, 1), cB + hstep, voffB); PG8_STAGE(PG8_SA(0, 1), cA + hstep, voffA);
    if (wr == 1) PG8_BAR;
    PG8_WAIT_V(4); PG8_BAR;
    PG8_STAGE(PG8_SB(1, 0), cB + kstep, voffB); PG8_STAGE(PG8_SA(1, 0), cA + kstep, voffA); PG8_STAGE(PG8_SB(1, 1), cB + hstep + kstep, voffB);
    PG8_WAIT_V(6); PG8_BAR;
    PG8_STAMP();
    for (;;) {
        const bool has_next = S.next(ui + 1, nxt);
        const char* nA = has_next ? (const char*)g.A + (size_t)nxt.pm * tstep : cA; const char* nB = has_next ? (const char*)g.Bt + (size_t)nxt.pn * tstep : cB;
        for (int t = 0; t < nt; t += 2) {
            const bool last = (t == nt - 2);
            const char* a1 = cA + (size_t)(t + 1) * kstep;
            const char* a2 = last ? nA : cA + (size_t)(t + 2) * kstep; const char* b2 = last ? nB : cB + (size_t)(t + 2) * kstep;
            const char* a3 = a2 + kstep; const char* b3 = b2 + kstep;
            if (last && has_next) S.a_ready(nxt);
            PG8_LDB(B0, 0, 0); PG8_SCHED; PG8_LDA(At, 0, 0); PG8_STAGE(PG8_SA(1, 1), a1 + hstep, voffA);
            PG8_WAIT_L(8); PG8_BAR; PG8_WAIT_L(0); PG8_MMA(0, 0, At, B0); PG8_BAR; PG8_SCHED;
            PG8_LDB(B1, 0, 1); PG8_STAGE(PG8_SB(0, 0), b2, voffB);
            PG8_BAR; PG8_WAIT_L(0); PG8_MMA(0, 1, At, B1); PG8_BAR;
            PG8_LDA(At, 0, 1); PG8_STAGE(PG8_SA(0, 0), a2, voffA);
            PG8_BAR; PG8_WAIT_L(0); PG8_MMA(1, 0, At, B0); PG8_BAR; PG8_SCHED;
            PG8_STAGE(PG8_SB(0, 1), b2 + hstep, voffB);
            PG8_WAIT_V(6); PG8_BAR; PG8_MMA(1, 1, At, B1); PG8_BAR;
            PG8_LDB(B0, 1, 0); PG8_SCHED; PG8_LDA(At, 1, 0); PG8_STAGE(PG8_SA(0, 1), a2 + hstep, voffA);
            PG8_WAIT_L(8); PG8_BAR; PG8_WAIT_L(0); PG8_MMA(0, 0, At, B0); PG8_BAR; PG8_SCHED;
            PG8_LDB(B1, 1, 1); PG8_STAGE(PG8_SB(1, 0), b3, voffB);
            PG8_BAR; PG8_WAIT_L(0); PG8_MMA(0, 1, At, B1); PG8_BAR;
            PG8_LDA(At, 1, 1); PG8_STAGE(PG8_SA(1, 0), a3, voffA);
            PG8_BAR; PG8_WAIT_L(0); PG8_MMA(1, 0, At, B0); PG8_BAR; PG8_SCHED;
            PG8_STAGE(PG8_SB(1, 1), b3 + hstep, voffB);
            PG8_WAIT_V(6); PG8_BAR; PG8_MMA(1, 1, At, B1); PG8_BAR;
        }
        PG8_STAMP();
        if constexpr (!Epi::AFTER_DRAIN) { E(acc, cur, wr, wc, fr, fq); S.done(cur); }
        PG8_STAMP();
        if (!has_next) break;
#pragma unroll
        for (int a = 0; a < 2; ++a)
#pragma unroll
            for (int b = 0; b < 2; ++b)
#pragma unroll
                for (int m = 0; m < 4; ++m)
#pragma unroll
                    for (int n = 0; n < 2; ++n) acc[a][b][m][n] = (f32x4){0.f, 0.f, 0.f, 0.f};
        cur = nxt; cA = nA; cB = nB; ++ui;
    }
    PG8_WAIT_V(0);
    if (wr == 0) PG8_BAR;
    PG8_BAR;
    if constexpr (Epi::AFTER_DRAIN) { E.fused(acc, cur, wr, wc, fr, fq, lds, wid, lane); S.done(cur); }
    PG8_STAMP();
    if (STAMP && wid == 0) { stamps[lane] = lane < nts ? (((unsigned long long)(unsigned)ts_hi << 32) | (unsigned)ts_lo) : 0ull;
        if (lane == 62) stamps[62] = rt_entry; if (lane == 63) stamps[63] = (unsigned long long)wall_clock64(); }
#undef PG8_STAMP
#undef PG8_SA
#undef PG8_SB
#undef PG8_STAGE
#undef PG8_LDA
#undef PG8_LDB
#undef PG8_MMA
#undef PG8_WAIT_V
#undef PG8_WAIT_L
#undef PG8_BAR
#undef PG8_SCHED
}
}
using pg8::bf16_t; using pg8::bf16x8; using pg8::f32x4; using pg8::u32x4; using pg8::cvt_pk_bf16; using pg8::Unit;
#define LAS __attribute__((address_space(3)))
typedef float f32x16 __attribute__((ext_vector_type(16)));
typedef unsigned u32x2 __attribute__((ext_vector_type(2)));

constexpr int D = 1024, DFF = 2816, NTOK = 12288, NCTX = 8192;
constexpr float ALPHA = 1.4142135623730951f;
constexpr float LN_EPS = 1e-5f;
constexpr int GS_LAT = 2 * 2048 + 32, GS_CTX = 2 * 256 + 32;

constexpr size_t SZ_WFI = (size_t)5632 * 1024 * 2, SZ_WFO = (size_t)1024 * 2816 * 2;
constexpr size_t WS_WFI = 0;
constexpr size_t WS_WFO = WS_WFI + 4 * SZ_WFI;
constexpr size_t WS_WQKV = WS_WFO + 4 * SZ_WFO;
constexpr size_t WS_WO = WS_WQKV + (size_t)3072 * 1024 * 2;
constexpr size_t WS_WHI = WS_WO + (size_t)1024 * 1024 * 2;
constexpr size_t WS_WHO = WS_WHI + (size_t)3072 * 1024 * 2;
constexpr size_t WS_MOD = WS_WHO + (size_t)1024 * 1024 * 2;
constexpr size_t WS_HID = WS_MOD + (size_t)2 * 3 * 9216 * 4;
constexpr size_t WS_KC = WS_HID + (size_t)(2048 + 256) * 64 * 4;
constexpr size_t WS_VCT = WS_KC + (size_t)2 * 256 * 1024 * 2;
constexpr size_t WS_GLAT = WS_VCT + (size_t)2 * 256 * 1024 * 2;
constexpr size_t WS_GCTX = WS_GLAT + (size_t)2 * 1024 * GS_LAT * 2;
constexpr size_t WS_X = WS_GCTX + (size_t)2 * 1024 * GS_CTX * 2;
constexpr size_t WS_Y = WS_X + (size_t)NTOK * D * 4;
constexpr size_t WS_H = WS_Y + (size_t)NTOK * D * 4;
constexpr size_t WS_M = WS_H + (size_t)NTOK * D * 2;
constexpr size_t WS_ACT = WS_M;
constexpr size_t WS_Q = WS_M;
constexpr size_t WS_K = WS_Q + (size_t)NTOK * D * 2;
constexpr size_t WS_VT = WS_K + (size_t)NTOK * D * 2;
constexpr size_t WS_UT = WS_M;
constexpr size_t WS_O = WS_M + (size_t)NTOK * 3072 * 2;
constexpr size_t WS_CTR = WS_O + (size_t)NTOK * D * 2;
constexpr size_t WS_END = WS_CTR + 256;
constexpr int LDS_BYTES = 81920 + 8 * 8256;

struct Params { const float* in[28]; float* out; unsigned char* ws; int ph_lo, ph_hi; };

__device__ __forceinline__ float bf2f(bf16_t b) { return __uint_as_float(((unsigned)b) << 16); }
__device__ __forceinline__ float bflo(unsigned w) { return __uint_as_float(w << 16); }
__device__ __forceinline__ float bfhi(unsigned w) { return __uint_as_float(w & 0xffff0000u); }
__device__ __forceinline__ bf16_t f2bf(float f) { return (bf16_t)(cvt_pk_bf16(f, 0.f) & 0xffffu); }
__device__ __forceinline__ float silu_f(float g) { return g * __builtin_amdgcn_rcpf(1.0f + __expf(-g)); }
__device__ __forceinline__ bf16x8 as_bf16x8(u32x4 v) { union { u32x4 u; bf16x8 b; } x; x.u = v; return x.b; }

struct EpiSwiglu {
    static constexpr bool PERM = true, AFTER_DRAIN = false;
    bf16_t* O;
    __device__ __forceinline__ void operator()(const f32x4 (&acc)[2][2][4][2], const Unit& u, int wr, int wc, int fr, int fq) const {
        const int row0 = u.pm * 256 + wr * 64 + fr, col0 = u.pn * 128 + wc * 32 + 8 * fq;
#pragma unroll
        for (int ai = 0; ai < 2; ++ai)
#pragma unroll
            for (int m = 0; m < 4; ++m) {
                bf16_t* rowp = O + (size_t)(row0 + ai * 128 + m * 16) * DFF + col0;
                const f32x4 g0 = acc[ai][0][m][0], g1 = acc[ai][0][m][1], u0 = acc[ai][1][m][0], u1 = acc[ai][1][m][1];
                u32x4 w;
                w.x = cvt_pk_bf16(silu_f(g0[0]) * u0[0], silu_f(g0[1]) * u0[1]); w.y = cvt_pk_bf16(silu_f(g0[2]) * u0[2], silu_f(g0[3]) * u0[3]);
                w.z = cvt_pk_bf16(silu_f(g1[0]) * u1[0], silu_f(g1[1]) * u1[1]); w.w = cvt_pk_bf16(silu_f(g1[2]) * u1[2], silu_f(g1[3]) * u1[3]);
                *(u32x4*)rowp = w;
            }
    }
};
struct EpiResid {
    static constexpr bool PERM = false, AFTER_DRAIN = false;
    const float* xa; const float* xb; float* Y; const float* modl; int gidx; float gscale;
    __device__ __forceinline__ void operator()(const f32x4 (&acc)[2][2][4][2], const Unit& u, int wr, int wc, int fr, int fq) const {
        const int row0 = u.pm * 256 + wr * 64 + fr, col0 = u.pn * 256 + wc * 32 + 4 * fq;
        const int ci = u.pm < 32 ? 0 : (u.pm < 40 ? 1 : 2);
        const float* gate = modl + ci * 9216 + gidx * 1024 + col0;
        f32x4 gv[2][2];
#pragma unroll
        for (int bj = 0; bj < 2; ++bj)
#pragma unroll
            for (int n = 0; n < 2; ++n) gv[bj][n] = *(const f32x4*)(gate + bj * 128 + n * 16) * gscale;
#pragma unroll
        for (int ai = 0; ai < 2; ++ai)
#pragma unroll
            for (int m = 0; m < 4; ++m) {
                const int row = row0 + ai * 128 + m * 16;
                const float* xr = (row < NCTX ? xa + (size_t)row * D : xb + (size_t)(row - NCTX) * D) + col0;
                float* yr = Y + (size_t)row * D + col0;
#pragma unroll
                for (int bj = 0; bj < 2; ++bj)
#pragma unroll
                    for (int n = 0; n < 2; ++n) { const f32x4 xv = *(const f32x4*)(xr + bj * 128 + n * 16); *(f32x4*)(yr + bj * 128 + n * 16) = xv * ALPHA + gv[bj][n] * acc[ai][bj][m][n]; }
            }
    }
};
__device__ __forceinline__ void store_T(const f32x4 (&acc)[2][2][4][2], const Unit& u, int wr, int wc, int fr, int fq, bf16_t* T, int C, int colt) {
    const bool lat = u.pm >= 32;
    const int L = lat ? 2048 : 256;
    const int row0 = u.pm * 256 + wr * 64 + fr;
#pragma unroll
    for (int ai = 0; ai < 2; ++ai)
#pragma unroll
        for (int m = 0; m < 4; ++m) {
            const int row = row0 + ai * 128 + m * 16;
            const int rr = lat ? row - NCTX : row;
            const int seq = lat ? (rr >> 11) : (rr >> 8), t = lat ? (rr & 2047) : (rr & 255);
            bf16_t* base = T + (lat ? (size_t)NCTX * C : (size_t)0) + (size_t)seq * C * L + t;
#pragma unroll
            for (int bj = 0; bj < 2; ++bj)
#pragma unroll
                for (int n = 0; n < 2; ++n)
#pragma unroll
                    for (int j = 0; j < 4; ++j) { const int col = colt + bj * 128 + wc * 32 + 8 * fq + 4 * n + j; base[(size_t)col * L] = f2bf(acc[ai][bj][m][n][j]); }
        }
}
struct EpiQKV {
    static constexpr bool PERM = true, AFTER_DRAIN = false;
    bf16_t* Q; bf16_t* Kb; bf16_t* Vt; float* outk; float* outv;
    __device__ __forceinline__ void operator()(const f32x4 (&acc)[2][2][4][2], const Unit& u, int wr, int wc, int fr, int fq) const {
        const int sel = u.pn >> 2, colt = (u.pn & 3) * 256;
        const int row0 = u.pm * 256 + wr * 64 + fr, col0 = colt + wc * 32 + 8 * fq;
        if (sel == 2) store_T(acc, u, wr, wc, fr, fq, Vt, 1024, colt);
#pragma unroll
        for (int ai = 0; ai < 2; ++ai)
#pragma unroll
            for (int m = 0; m < 4; ++m) {
                const int row = row0 + ai * 128 + m * 16;
#pragma unroll
                for (int bj = 0; bj < 2; ++bj) {
                    const f32x4 v0 = acc[ai][bj][m][0], v1 = acc[ai][bj][m][1];
                    const size_t off = (size_t)row * D + col0 + bj * 128;
                    if (sel == 0) { u32x4 w; w.x = cvt_pk_bf16(v0[0] * 0.125f, v0[1] * 0.125f); w.y = cvt_pk_bf16(v0[2] * 0.125f, v0[3] * 0.125f); w.z = cvt_pk_bf16(v1[0] * 0.125f, v1[1] * 0.125f); w.w = cvt_pk_bf16(v1[2] * 0.125f, v1[3] * 0.125f); *(u32x4*)(Q + off) = w; }
                    else if (sel == 1) { u32x4 w; w.x = cvt_pk_bf16(v0[0], v0[1]); w.y = cvt_pk_bf16(v0[2], v0[3]); w.z = cvt_pk_bf16(v1[0], v1[1]); w.w = cvt_pk_bf16(v1[2], v1[3]); *(u32x4*)(Kb + off) = w;
                        if (row < NCTX) { *(f32x4*)(outk + off) = v0; *(f32x4*)(outk + off + 4) = v1; } }
                    else { if (row < NCTX) { *(f32x4*)(outv + off) = v0; *(f32x4*)(outv + off + 4) = v1; } }
                }
            }
    }
};
struct EpiHyIn {
    static constexpr bool PERM = true, AFTER_DRAIN = false;
    bf16_t* Ut;
    __device__ __forceinline__ void operator()(const f32x4 (&acc)[2][2][4][2], const Unit& u, int wr, int wc, int fr, int fq) const {
        store_T(acc, u, wr, wc, fr, fq, Ut, 3072, u.pn * 256);
    }
};

template <class Epi>
__device__ __forceinline__ void run_gemm(unsigned char* shm, const bf16_t* A, const bf16_t* Bt, int N, int K, const Epi& E) {
    pg8::Gemm g; g.A = A; g.Bt = Bt; g.M = NTOK; g.N = N; g.K = K;
    pg8::StaticOrder S; S.init(NTOK, N, (int)gridDim.x, (int)blockIdx.x);
    pg8::gemm_phase<Epi, pg8::StaticOrder, false>((PG8_LAS unsigned char*)shm, g, S, E, nullptr);
}

__device__ __forceinline__ int take_ticket(unsigned* ctr, int lane) {
    unsigned t = 0;
    if (lane == 0) t = __hip_atomic_fetch_add(ctr, 1u, __ATOMIC_RELAXED, __HIP_MEMORY_SCOPE_AGENT);
    return (int)__builtin_amdgcn_readfirstlane(t);
}
__device__ __forceinline__ float wave_sum(float v) {
#pragma unroll
    for (int o = 1; o < 64; o <<= 1) v += __shfl_xor(v, o);
    return v;
}
__device__ __forceinline__ void mod_wave(const Params& p, int l, int n0, const LAS float* sc, int lane) {
    const int kg = lane >> 5, col = lane & 31;
    const float* w = p.in[6] + (size_t)l * 1024 * 9216 + n0 + col;
    float a0 = 0.f, a1 = 0.f, a2 = 0.f;
#pragma unroll 16
    for (int k = kg * 512; k < kg * 512 + 512; ++k) { const float wv = w[(size_t)k * 9216]; a0 += sc[k] * wv; a1 += sc[1024 + k] * wv; a2 += sc[2048 + k] * wv; }
    a0 += __shfl_xor(a0, 32); a1 += __shfl_xor(a1, 32); a2 += __shfl_xor(a2, 32);
    if (lane < 32) { const float bb = p.in[7][l * 9216 + n0 + col]; float* m = (float*)(p.ws + WS_MOD) + (size_t)l * 3 * 9216 + n0 + col;
        m[0] = a0 + bb; m[9216] = a1 + bb; m[2 * 9216] = a2 + bb; }
}
__device__ __forceinline__ void hid_wave(const Params& p, int r, LAS float* scr, int lane) {
    const bool lat = r < 512;
    const int L = lat ? 2048 : 256, pos0 = (lat ? r : r - 512) * 4;
    LAS float* zf = scr; LAS float* h1 = scr + 160;
    for (int idx = lane; idx < 132; idx += 64) {
        const int pp = idx / 33, j = idx - pp * 33, pos = pos0 + pp;
        float v;
        if (j == 0) v = (float)pos / (float)(L - 1);
        else { const int bi = (j - 1) & 15; const float band = 1e-4f + (float)bi * ((15.0f - 1e-4f) / 15.0f);
            const float rev = __builtin_amdgcn_fractf(((float)pos / (float)L) * band);
            v = j <= 16 ? __builtin_amdgcn_cosf(rev) : -__builtin_amdgcn_sinf(rev); }
        zf[idx] = v;
    }
    const int j = lane;
    float a[4]; { const float b = p.in[19][j]; a[0] = a[1] = a[2] = a[3] = b; }
#pragma unroll 11
    for (int i = 0; i < 33; ++i) { const float w = p.in[18][i * 64 + j]; a[0] += zf[i] * w; a[1] += zf[33 + i] * w; a[2] += zf[66 + i] * w; a[3] += zf[99 + i] * w; }
    { const float f = p.in[20][j] * 0.15915494309189535f;
#pragma unroll
        for (int pp = 0; pp < 4; ++pp) h1[pp * 64 + j] = __builtin_amdgcn_sinf(__builtin_amdgcn_fractf(a[pp] * f)); }
    float b[4]; { const float bb = p.in[22][j]; b[0] = b[1] = b[2] = b[3] = bb; }
#pragma unroll 16
    for (int i = 0; i < 64; ++i) { const float w = p.in[21][i * 64 + j]; b[0] += h1[i] * w; b[1] += h1[64 + i] * w; b[2] += h1[128 + i] * w; b[3] += h1[192 + i] * w; }
    float* hid = (float*)(p.ws + WS_HID) + (lat ? 0 : 2048 * 64);
    { const float f = p.in[23][j] * 0.15915494309189535f;
#pragma unroll
        for (int pp = 0; pp < 4; ++pp) hid[(pos0 + pp) * 64 + j] = __builtin_amdgcn_sinf(__builtin_amdgcn_fractf(b[pp] * f)); }
}
__device__ __forceinline__ void transpose_wave(const Params& p, int r, LAS float* tile, int lane) {
    const float* W; bf16_t* WT; int K, N, perm = 0;
    if (r < 5632) { const int mi = r / 1408; r %= 1408; W = p.in[10] + (size_t)mi * 1024 * 5632; WT = (bf16_t*)(p.ws + WS_WFI + mi * SZ_WFI); K = 1024; N = 5632; perm = 1; }
    else if ((r -= 5632) < 2816) { const int mi = r / 704; r %= 704; W = p.in[11] + (size_t)mi * 2816 * 1024; WT = (bf16_t*)(p.ws + WS_WFO + mi * SZ_WFO); K = 2816; N = 1024; }
    else if ((r -= 2816) < 768) { W = p.in[12]; WT = (bf16_t*)(p.ws + WS_WQKV); K = 1024; N = 3072; }
    else if ((r -= 768) < 256) { W = p.in[13]; WT = (bf16_t*)(p.ws + WS_WO); K = 1024; N = 1024; }
    else if ((r -= 256) < 768) { W = p.in[15]; WT = (bf16_t*)(p.ws + WS_WHI); K = 1024; N = 3072; }
    else { r -= 768; W = p.in[27]; WT = (bf16_t*)(p.ws + WS_WHO); K = 1024; N = 1024; }
    const int ntn = N / 64, k0 = (r / ntn) * 64, n0 = (r % ntn) * 64;
    int nd0 = n0;
    if (perm) { const int hf = n0 >= DFF, nn = hf ? n0 - DFF : n0; nd0 = (nn >> 7) * 256 + hf * 128 + (nn & 127); }
    const int lr = lane >> 4, lc = (lane & 15) * 4;
    const float* src = W + (size_t)(k0 + lr) * N + n0 + lc;
    f32x4 v[16];
#pragma unroll
    for (int i = 0; i < 16; ++i) v[i] = *(const f32x4*)(src + (size_t)(4 * i) * N);
#pragma unroll
    for (int i = 0; i < 16; ++i) { LAS float* t = tile + (4 * i + lr) * 65 + lc; t[0] = v[i][0]; t[1] = v[i][1]; t[2] = v[i][2]; t[3] = v[i][3]; }
    const int ch = lane & 7;
#pragma unroll
    for (int j = 0; j < 8; ++j) { const int n = (lane >> 3) + 8 * j; const LAS float* s = tile + (8 * ch) * 65 + n;
        u32x4 o; o.x = cvt_pk_bf16(s[0], s[65]); o.y = cvt_pk_bf16(s[2 * 65], s[3 * 65]); o.z = cvt_pk_bf16(s[4 * 65], s[5 * 65]); o.w = cvt_pk_bf16(s[6 * 65], s[7 * 65]);
        *(u32x4*)(WT + (size_t)(nd0 + n) * K + k0 + 8 * ch) = o; }
}
constexpr int P0_MOD = 64, P0_HID = 576, P0_KC = 128, P0_VC = 128, P0_TR = 10496, P0_TOTAL = P0_MOD + P0_HID + P0_KC + P0_VC + P0_TR;
__device__ __forceinline__ void p0_phase(const Params& p, unsigned char* shm) {
    const int tid = threadIdx.x, wid = tid >> 6, lane = tid & 63;
    LAS float* sc = (LAS float*)(LAS unsigned char*)shm;
    LAS float* tile = (LAS float*)((LAS unsigned char*)shm + 12288 + wid * 16640);
    for (int i = tid; i < 3072; i += 512) { const int ci = i >> 10, k = i & 1023; const float v = ci == 0 ? p.in[5][k] : p.in[4][(ci - 1) * 1024 + k]; sc[i] = v / (1.0f + __expf(-v)); }
    __syncthreads();
    unsigned* ctr = (unsigned*)(p.ws + WS_CTR);
    int it = take_ticket(ctr, lane);
    while (it < P0_TOTAL) {
        const int nxt = take_ticket(ctr, lane);
        int r = it;
        if (r < P0_MOD) mod_wave(p, 0, r * 32, sc, lane);
        else if ((r -= P0_MOD) < P0_HID) hid_wave(p, r, tile, lane);
        else if ((r -= P0_HID) < P0_KC) {
#pragma unroll
            for (int j = 0; j < 8; ++j) { const size_t e = ((size_t)r * 512 + j * 64 + lane) * 8; const f32x4 a = *(const f32x4*)(p.in[2] + e), b = *(const f32x4*)(p.in[2] + e + 4);
                u32x4 o; o.x = cvt_pk_bf16(a[0], a[1]); o.y = cvt_pk_bf16(a[2], a[3]); o.z = cvt_pk_bf16(b[0], b[1]); o.w = cvt_pk_bf16(b[2], b[3]);
                *(u32x4*)((bf16_t*)(p.ws + WS_KC) + e) = o; } }
        else if ((r -= P0_KC) < P0_VC) {
            for (int j = 0; j < 8; ++j) { const int g = r * 512 + j * 64 + lane;
                const int t = g & 255, c8 = (g >> 8) & 127, b = g >> 15;
                const float* src = p.in[3] + ((size_t)(b * 256 + t)) * 1024 + c8 * 8;
                const f32x4 a = *(const f32x4*)src, bb = *(const f32x4*)(src + 4);
                bf16_t* dst = (bf16_t*)(p.ws + WS_VCT) + ((size_t)b * 1024 + c8 * 8) * 256 + t;
                dst[0] = f2bf(a[0]); dst[256] = f2bf(a[1]); dst[512] = f2bf(a[2]); dst[768] = f2bf(a[3]);
                dst[1024] = f2bf(bb[0]); dst[1280] = f2bf(bb[1]); dst[1536] = f2bf(bb[2]); dst[1792] = f2bf(bb[3]); } }
        else { r -= P0_VC; transpose_wave(p, r, tile, lane); }
        it = nxt;
    }
}

__device__ __forceinline__ void row_do(const Params& p, int mode, int row, const float* Ysrc, float* Xout, const float* lng, const float* lnb, const float* modl, int shidx, int lane) {
    bf16_t* H = (bf16_t*)(p.ws + WS_H);
    const float* src = mode == 0 ? (row < NCTX ? p.in[0] + (size_t)row * D : p.in[1] + (size_t)(row - NCTX) * D) : Ysrc + (size_t)row * D;
    f32x4 v[4];
#pragma unroll
    for (int j = 0; j < 4; ++j) v[j] = *(const f32x4*)(src + lane * 4 + 256 * j);
    if (mode != 0) {
        float s = 0.f;
#pragma unroll
        for (int j = 0; j < 4; ++j) s += (v[j][0] + v[j][1]) + (v[j][2] + v[j][3]);
        const float mean = wave_sum(s) * (1.0f / D);
        float s2 = 0.f;
#pragma unroll
        for (int j = 0; j < 4; ++j) { v[j] = v[j] - mean; s2 += (v[j][0] * v[j][0] + v[j][1] * v[j][1]) + (v[j][2] * v[j][2] + v[j][3] * v[j][3]); }
        const float rstd = 1.0f / sqrtf(wave_sum(s2) * (1.0f / D) + LN_EPS);
#pragma unroll
        for (int j = 0; j < 4; ++j) { const f32x4 g = *(const f32x4*)(lng + lane * 4 + 256 * j), b = *(const f32x4*)(lnb + lane * 4 + 256 * j);
            v[j] = v[j] * rstd * g + b; *(f32x4*)(Xout + (size_t)row * D + lane * 4 + 256 * j) = v[j]; }
    }
    if (mode != 2) {
        const int ci = row < NCTX ? 0 : (row < NCTX + 2048 ? 1 : 2);
        const float* sh = modl + ci * 9216 + shidx * 1024, *scp = sh + 1024;
#pragma unroll
        for (int j = 0; j < 4; ++j) { const f32x4 a = *(const f32x4*)(sh + lane * 4 + 256 * j), s = *(const f32x4*)(scp + lane * 4 + 256 * j);
            const f32x4 h = v[j] * (s + 1.0f) + a; u32x2 w; w.x = cvt_pk_bf16(h[0], h[1]); w.y = cvt_pk_bf16(h[2], h[3]);
            *(u32x2*)(H + (size_t)row * D + lane * 4 + 256 * j) = w; }
    }
}
__device__ __forceinline__ void row_phase(const Params& p, int mode, const float* Ysrc, float* Xout, const float* lng, const float* lnb, const float* modl, int shidx) {
    const int lane = threadIdx.x & 63, gw = blockIdx.x * 8 + (threadIdx.x >> 6), ngw = gridDim.x * 8;
    for (int row = gw; row < NTOK; row += ngw) row_do(p, mode, row, Ysrc, Xout, lng, lnb, modl, shidx, lane);
}

__device__ __forceinline__ void gimg_wave(const Params& p, int job, int lane) {
    const int nblk = job >> 3, pch = job & 7, n0 = nblk * 32, o = n0 >> 11, dir = (n0 >> 10) & 1, nl = lane & 31, h = lane >> 5;
    const int c = (n0 & 1023) + nl;
    const float* w3 = p.in[24] + (size_t)(32 * h) * 4096 + n0 + nl;
    float bw[32];
#pragma unroll
    for (int kk = 0; kk < 32; ++kk) bw[kk] = w3[(size_t)kk * 4096];
    const float b3v = p.in[25][n0 + nl], hbv = p.in[26][o * 1024 + c];
    const float da = -3.0701134573253943f, db = -15.350567286626972f;
    const float delta = fabsf(da + (float)c * ((db - da) / 1023.0f));
#pragma unroll 1
    for (int blk = 0; blk < 9; ++blk) {
        const bool lat = blk < 8;
        const int L = lat ? 2048 : 256, GS = 2 * L + 32, pos0 = lat ? (pch * 8 + blk) * 32 : pch * 32;
        const float* hrow = (const float*)(p.ws + WS_HID) + (lat ? 0 : 2048 * 64) + (size_t)(pos0 + nl) * 64 + 32 * h;
        f32x4 af[8];
#pragma unroll
        for (int i = 0; i < 8; ++i) af[i] = *(const f32x4*)(hrow + 4 * i);
        f32x16 acc;
#pragma unroll
        for (int j = 0; j < 16; ++j) acc[j] = 0.f;
#pragma unroll
        for (int kk = 0; kk < 32; ++kk) acc = __builtin_amdgcn_mfma_f32_32x32x2f32(af[kk >> 2][kk & 3], bw[kk], acc, 0, 0, 0);
        bf16_t* im = (bf16_t*)(p.ws + (lat ? WS_GLAT : WS_GCTX)) + (size_t)(o * 1024 + c) * GS;
        const float tsc = -delta / (float)(L - 1);
#pragma unroll
        for (int rg = 0; rg < 4; ++rg) {
            const int q0 = pos0 + 8 * rg + 4 * h;
            float v[4];
#pragma unroll
            for (int j = 0; j < 4; ++j) v[j] = (acc[4 * rg + j] + b3v) * __expf((float)(q0 + j) * tsc);
            if (dir == 0) {
                if (q0 == 0) v[0] += hbv;
                im[L - q0] = f2bf(v[0]); *(unsigned*)(im + L - q0 - 2) = cvt_pk_bf16(v[2], v[1]); im[L - q0 - 3] = f2bf(v[3]);
            } else {
                if (q0 == 0) { im[L + 1] = f2bf(v[1]); *(unsigned*)(im + L + 2) = cvt_pk_bf16(v[2], v[3]); }
                else { u32x2 w; w.x = cvt_pk_bf16(v[0], v[1]); w.y = cvt_pk_bf16(v[2], v[3]); *(u32x2*)(im + L + q0) = w; }
            }
        }
        if (dir == 1) {
            const bool last = lat ? (pch == 7 && blk == 7) : (pch == 7);
            if (last) { const u32x4 z = {0u, 0u, 0u, 0u}; *(u32x4*)(im + 2 * L + 16 * h) = z; *(u32x4*)(im + 2 * L + 16 * h + 8) = z; }
            if (pos0 == 0 && h == 0) im[0] = 0;
        }
    }
}
constexpr int P1_MOD = 512, P1_GIMG = 1024, P1_ROWS = 1536, P1_TOTAL = P1_MOD + P1_GIMG + P1_ROWS;
__device__ __forceinline__ void p1_phase(const Params& p, unsigned char* shm) {
    const int tid = threadIdx.x, lane = tid & 63;
    LAS float* sc = (LAS float*)(LAS unsigned char*)shm;
    for (int i = tid; i < 3072; i += 512) { const int ci = i >> 10, k = i & 1023; const float v = ci == 0 ? p.in[5][k] : p.in[4][(ci - 1) * 1024 + k]; sc[i] = v / (1.0f + __expf(-v)); }
    __syncthreads();
    unsigned* ctr = (unsigned*)(p.ws + WS_CTR) + 16;
    int it = take_ticket(ctr, lane);
    while (it < P1_TOTAL) {
        const int nxt = take_ticket(ctr, lane);
        int r = it;
        if (r < P1_MOD) { const int cc = r + 64; mod_wave(p, cc / 288, (cc % 288) * 32, sc, lane); }
        else if ((r -= P1_MOD) < P1_GIMG) gimg_wave(p, r, lane);
        else { r -= P1_GIMG;
            for (int j = 0; j < 8; ++j) row_do(p, 0, r * 8 + j, nullptr, nullptr, nullptr, nullptr, (const float*)(p.ws + WS_MOD), 0, lane); }
        it = nxt;
    }
}


struct AttnArgs { const bf16_t *Q, *K, *Vt, *Kc, *Vct; const float* rpb; bf16_t* O; };
template <bool LAT>
__device__ __forceinline__ void attn_wave(const AttnArgs& A, int b, int h, int qrow0, int r, int n, int lane) {
    constexpr int NKB = LAT ? 32 : 16;
    const int fr = lane & 15, fq = lane >> 4;
    const bf16_t* qp = A.Q + (size_t)(qrow0 + fr) * D + h * 64 + 8 * fq;
    const bf16x8 q0 = *(const bf16x8*)qp, q1 = *(const bf16x8*)(qp + 32);
    int rs = 0, kstart = 0;
    if (LAT) { rs = min(max(r - 4, 0), 24); kstart = n == 0 ? 0 : (n == 1 ? 8 : (n == 2 ? 24 : 32)); }
    f32x4 s[NKB];
#pragma unroll
    for (int kb = 0; kb < NKB; ++kb) {
        const bf16_t* kp;
        if (LAT && kb < 16) kp = A.K + (size_t)(NCTX + b * 2048 + (rs + (kb >> 1)) * 64 + kstart + (kb & 1) * 16 + fr) * D;
        else if (LAT) kp = A.Kc + (size_t)(b * 256 + (kb - 16) * 16 + fr) * D;
        else kp = A.K + (size_t)(b * 256 + kb * 16 + fr) * D;
        kp += h * 64 + 8 * fq;
        const bf16x8 a0 = *(const bf16x8*)kp, a1 = *(const bf16x8*)(kp + 32);
        f32x4 z = {0.f, 0.f, 0.f, 0.f};
        z = __builtin_amdgcn_mfma_f32_16x16x32_bf16(a0, q0, z, 0, 0, 0);
        z = __builtin_amdgcn_mfma_f32_16x16x32_bf16(a1, q1, z, 0, 0, 0);
        s[kb] = z;
    }
    if (LAT) {
        const int qcol = n * 16 + fr, cstart = min(max(qcol - 8, 0), 48);
#pragma unroll
        for (int kb = 0; kb < 16; ++kb) {
            const int drow = rs + (kb >> 1) - r + 7;
            const float* bp = A.rpb + h * 465 + drow * 31;
#pragma unroll
            for (int i = 0; i < 4; ++i) {
                const int kc = kstart + (kb & 1) * 16 + 4 * fq + i;
                const bool ok = kc >= cstart && kc < cstart + 16;
                const int dcol = min(max(kc - qcol, -15), 15) + 15;
                const float bias = bp[dcol];
                s[kb][i] = ok ? s[kb][i] + bias : -INFINITY;
            }
        }
    }
    float mx = -INFINITY;
#pragma unroll
    for (int kb = 0; kb < NKB; ++kb) mx = fmaxf(fmaxf(fmaxf(s[kb][0], s[kb][1]), fmaxf(s[kb][2], s[kb][3])), mx);
    mx = fmaxf(mx, __shfl_xor(mx, 16)); mx = fmaxf(mx, __shfl_xor(mx, 32));
    float sum = 0.f;
#pragma unroll
    for (int kb = 0; kb < NKB; ++kb)
#pragma unroll
        for (int i = 0; i < 4; ++i) { const float e = __expf(s[kb][i] - mx); s[kb][i] = e; sum += e; }
    sum += __shfl_xor(sum, 16); sum += __shfl_xor(sum, 32);
    const float inv = 1.0f / sum;
    f32x4 o[4];
#pragma unroll
    for (int db = 0; db < 4; ++db) o[db] = (f32x4){0.f, 0.f, 0.f, 0.f};
#pragma unroll
    for (int pp = 0; pp < NKB / 2; ++pp) {
        u32x4 pw; pw.x = cvt_pk_bf16(s[2 * pp][0], s[2 * pp][1]); pw.y = cvt_pk_bf16(s[2 * pp][2], s[2 * pp][3]);
        pw.z = cvt_pk_bf16(s[2 * pp + 1][0], s[2 * pp + 1][1]); pw.w = cvt_pk_bf16(s[2 * pp + 1][2], s[2 * pp + 1][3]);
        const bf16x8 pf = as_bf16x8(pw);
#pragma unroll
        for (int db = 0; db < 4; ++db) {
            const int col = h * 64 + 16 * db + fr;
            const bf16_t* vp;
            if (LAT && pp < 8) vp = A.Vt + (size_t)NCTX * 1024 + (size_t)b * (1024 * 2048) + (size_t)col * 2048 + (rs + pp) * 64 + kstart + 4 * fq;
            else if (LAT) vp = A.Vct + (size_t)b * (1024 * 256) + col * 256 + (pp - 8) * 32 + 4 * fq;
            else vp = A.Vt + (size_t)b * (1024 * 256) + col * 256 + pp * 32 + 4 * fq;
            const u32x2 v0 = *(const u32x2*)vp, v1 = *(const u32x2*)(vp + 16);
            u32x4 vw; vw.x = v0.x; vw.y = v0.y; vw.z = v1.x; vw.w = v1.y;
            o[db] = __builtin_amdgcn_mfma_f32_16x16x32_bf16(as_bf16x8(vw), pf, o[db], 0, 0, 0);
        }
    }
    bf16_t* op = A.O + (size_t)(qrow0 + fr) * D + h * 64 + 4 * fq;
#pragma unroll
    for (int db = 0; db < 4; ++db) { u32x2 w; w.x = cvt_pk_bf16(o[db][0] * inv, o[db][1] * inv); w.y = cvt_pk_bf16(o[db][2] * inv, o[db][3] * inv); *(u32x2*)(op + 16 * db) = w; }
}
__device__ __forceinline__ void attn_phase(const Params& p) {
    AttnArgs A; A.Q = (const bf16_t*)(p.ws + WS_Q); A.K = (const bf16_t*)(p.ws + WS_K); A.Vt = (const bf16_t*)(p.ws + WS_VT);
    A.Kc = (const bf16_t*)(p.ws + WS_KC); A.Vct = (const bf16_t*)(p.ws + WS_VCT); A.rpb = p.in[14]; A.O = (bf16_t*)(p.ws + WS_O);
    const int w = threadIdx.x >> 6, lane = threadIdx.x & 63;
    for (int it = blockIdx.x; it < 512 + 1024; it += gridDim.x) {
        if (it < 512) { const int b = it >> 8, r = (it >> 3) & 31, h = (it & 7) * 2 + (w >> 2), n = w & 3;
            attn_wave<true>(A, b, h, NCTX + b * 2048 + r * 64 + n * 16, r, n, lane); }
        else { const int i2 = it - 512; const int b = i2 >> 5, h = (i2 >> 1) & 15, qc = (i2 & 1) * 8 + w;
            attn_wave<false>(A, b, h, b * 256 + qc * 16, 0, 0, lane); }
    }
}

__device__ __forceinline__ void hyena_item(const Params& p, int item, LAS unsigned char* lds) {
    const int tid = threadIdx.x, wid = tid >> 6, lane = tid & 63, a = lane & 31, hh = lane >> 5;
    const bool lat = item < 128;
    const int L = lat ? 2048 : 256, lognb = lat ? 6 : 3, nb = 1 << lognb;
    const int cgp = lat ? item : ((item - 128) >> 1), seq0 = lat ? 0 : ((item - 128) & 1) * 16;
    const int c = cgp * 8 + wid;
    const bf16_t* ut = (const bf16_t*)(p.ws + WS_UT) + (lat ? (size_t)NCTX * 3072 : (size_t)0);
    const size_t sstr = (size_t)3072 * L;
    const int GS = 2 * L + 32;
    const bf16_t* gim = (const bf16_t*)(p.ws + (lat ? WS_GLAT : WS_GCTX));
    LAS unsigned char* zb = lds + wid * 10240;
    LAS unsigned char* gb = lds + 81920 + wid * 8256;
    const float* cw = p.in[16]; const float* cb = p.in[17];
    {
        const float w0 = cw[c], w1 = cw[3072 + c], w2 = cw[6144 + c], bb = cb[c];
        for (int it8 = 0; it8 < 8; ++it8) {
            const int ch = it8 * 64 + lane, col = ch >> 2, part = ch & 3, bl = col >> lognb, i = col & (nb - 1), t0 = 32 * i + 8 * part;
            const bf16_t* ptr = ut + (size_t)(seq0 + bl) * sstr + (size_t)c * L + t0;
            const u32x4 mv = *(const u32x4*)ptr;
            float e[10];
            e[0] = t0 > 0 ? bf2f(ptr[-1]) : 0.f; e[9] = (t0 + 8 < L) ? bf2f(ptr[8]) : 0.f;
            e[1] = bflo(mv.x); e[2] = bfhi(mv.x); e[3] = bflo(mv.y); e[4] = bfhi(mv.y); e[5] = bflo(mv.z); e[6] = bfhi(mv.z); e[7] = bflo(mv.w); e[8] = bfhi(mv.w);
            float o8[8];
#pragma unroll
            for (int j = 0; j < 8; ++j) o8[j] = w0 * e[j] + w1 * e[j + 1] + w2 * e[j + 2] + bb;
            u32x4 ov; ov.x = cvt_pk_bf16(o8[0], o8[1]); ov.y = cvt_pk_bf16(o8[2], o8[3]); ov.z = cvt_pk_bf16(o8[4], o8[5]); ov.w = cvt_pk_bf16(o8[6], o8[7]);
            *(LAS u32x4*)(zb + col * 80 + part * 16) = ov;
        }
    }
    f32x16 acc[4];
#pragma unroll 1
    for (int o = 0; o < 2; ++o) {
        { const u32x4* src = (const u32x4*)(gim + (size_t)(o * 1024 + c) * GS); const int nch = GS / 8;
            for (int i = lane; i < nch; i += 64) *(LAS u32x4*)(gb + i * 16) = src[i]; }
#pragma unroll
        for (int q = 0; q < 4; ++q)
#pragma unroll
            for (int j = 0; j < 16; ++j) acc[q][j] = 0.f;
        for (int k = -(nb - 1); k <= nb - 1; ++k) {
#pragma unroll
            for (int s = 0; s < 2; ++s) {
                const int i0 = L - 32 * k - a + 16 * s + 8 * hh;
                const LAS unsigned* gw = (const LAS unsigned*)gb + (i0 >> 1);
                const unsigned g0 = gw[0], g1 = gw[1], g2 = gw[2], g3 = gw[3], g4 = gw[4];
                const unsigned sh = (unsigned)(i0 & 1) * 2u;
                u32x4 af; af.x = __builtin_amdgcn_alignbyte(g1, g0, sh); af.y = __builtin_amdgcn_alignbyte(g2, g1, sh); af.z = __builtin_amdgcn_alignbyte(g3, g2, sh); af.w = __builtin_amdgcn_alignbyte(g4, g3, sh);
                const bf16x8 afr = as_bf16x8(af);
#pragma unroll
                for (int q = 0; q < 4; ++q) {
                    const int col = 32 * q + a, src = (col & (nb - 1)) - k;
                    u32x4 bv = {0u, 0u, 0u, 0u};
                    if ((unsigned)src < (unsigned)nb) bv = *(const LAS u32x4*)(zb + (col - k) * 80 + 32 * s + 16 * hh);
                    acc[q] = __builtin_amdgcn_mfma_f32_32x32x16_bf16(afr, as_bf16x8(bv), acc[q], 0, 0, 0);
                }
            }
        }
        const int c3 = (o + 1) * 1024 + c;
        const float w0 = cw[c3], w1 = cw[3072 + c3], w2 = cw[6144 + c3], bb = cb[c3];
        if (o == 1) __syncthreads();
#pragma unroll
        for (int q = 0; q < 4; ++q) {
            const int col = 32 * q + a, bl = col >> lognb, i = col & (nb - 1);
            const bf16_t* base = ut + (size_t)(seq0 + bl) * sstr + (size_t)c3 * L + 32 * i;
#pragma unroll
            for (int rg = 0; rg < 4; ++rg) {
                const int a0 = 8 * rg + 4 * hh, t = 32 * i + a0;
                const u32x2 mv = *(const u32x2*)(base + a0);
                float e[6];
                e[0] = t > 0 ? bf2f(base[a0 - 1]) : 0.f; e[5] = (t + 4 < L) ? bf2f(base[a0 + 4]) : 0.f;
                e[1] = bflo(mv.x); e[2] = bfhi(mv.x); e[3] = bflo(mv.y); e[4] = bfhi(mv.y);
                float z[4];
#pragma unroll
                for (int j = 0; j < 4; ++j) z[j] = acc[q][4 * rg + j] * (w0 * e[j] + w1 * e[j + 1] + w2 * e[j + 2] + bb);
                if (o == 0) { u32x2 w; w.x = cvt_pk_bf16(z[0], z[1]); w.y = cvt_pk_bf16(z[2], z[3]); *(LAS u32x2*)(zb + col * 80 + a0 * 2) = w; }
                else {
                    LAS bf16_t* stg = (LAS bf16_t*)lds;
#pragma unroll
                    for (int j = 0; j < 4; ++j) stg[((a0 + j) * 128 + col) * 8 + wid] = f2bf(z[j]);
                }
            }
        }
    }
    __syncthreads();
    {
        bf16_t* O = (bf16_t*)(p.ws + WS_O);
        for (int idx = tid; idx < 4096; idx += 512) {
            const int tin = idx >> 7, col = idx & 127, bl = col >> lognb, i = col & (nb - 1), sq = seq0 + bl;
            const int tok = (lat ? NCTX + sq * 2048 : sq * 256) + 32 * i + tin;
            *(u32x4*)(O + (size_t)tok * D + cgp * 8) = *(const LAS u32x4*)(lds + idx * 16);
        }
    }
    __syncthreads();
}

constexpr int N_PHASES = 22;
__device__ __forceinline__ void run_phase(const Params& p, int ph, unsigned char* shm) {
    const float* mod = (const float*)(p.ws + WS_MOD);
    float* X = (float*)(p.ws + WS_X); float* Y = (float*)(p.ws + WS_Y);
    const bf16_t* H = (const bf16_t*)(p.ws + WS_H);
    if (ph == 0) { p0_phase(p, shm); return; }
    if (ph == 1) { p1_phase(p, shm); return; }
    const int l = (ph - 2) / 10, sp = (ph - 2) % 10;
    const float* modl = mod + (size_t)l * 3 * 9216;
    if (sp == 0 || sp == 7) {
        const int s = sp == 0 ? 0 : 1;
        EpiSwiglu E; E.O = (bf16_t*)(p.ws + WS_ACT);
        run_gemm(shm, H, (const bf16_t*)(p.ws + WS_WFI + (size_t)(l * 2 + s) * SZ_WFI), 5632, 1024, E);
    } else if (sp == 1 || sp == 8 || sp == 5) {
        EpiResid E; E.Y = Y; E.modl = modl;
        const bool first = (l == 0 && sp == 1);
        E.xa = first ? p.in[0] : X; E.xb = first ? p.in[1] : X + (size_t)NCTX * D;
        const bf16_t* A; const bf16_t* Bt; int K;
        if (sp == 5) { A = (const bf16_t*)(p.ws + WS_O); Bt = (const bf16_t*)(p.ws + (l == 0 ? WS_WO : WS_WHO)); K = 1024; E.gidx = 5; E.gscale = 1.0f; }
        else { const int s = sp == 1 ? 0 : 1; A = (const bf16_t*)(p.ws + WS_ACT); Bt = (const bf16_t*)(p.ws + WS_WFO + (size_t)(l * 2 + s) * SZ_WFO); K = DFF; E.gidx = sp == 1 ? 2 : 8; E.gscale = 0.5f; }
        run_gemm(shm, A, Bt, 1024, K, E);
    } else if (sp == 2 || sp == 6 || sp == 9) {
        const int k = sp == 2 ? 0 : (sp == 6 ? 1 : 2);
        const float* lng = p.in[8] + (size_t)(l * 3 + k) * D; const float* lnb = p.in[9] + (size_t)(l * 3 + k) * D;
        if (sp == 9 && l == 1) row_phase(p, 2, Y, p.out, lng, lnb, modl, 0);
        else if (sp == 9) row_phase(p, 1, Y, X, lng, lnb, modl + 3 * 9216, 0);
        else row_phase(p, 1, Y, X, lng, lnb, modl, sp == 2 ? 3 : 6);
    } else if (sp == 3) {
        if (l == 0) { EpiQKV E; E.Q = (bf16_t*)(p.ws + WS_Q); E.Kb = (bf16_t*)(p.ws + WS_K); E.Vt = (bf16_t*)(p.ws + WS_VT); E.outk = p.out + (size_t)NTOK * D; E.outv = p.out + (size_t)NTOK * D + (size_t)NCTX * D;
            run_gemm(shm, H, (const bf16_t*)(p.ws + WS_WQKV), 3072, 1024, E); }
        else { EpiHyIn E; E.Ut = (bf16_t*)(p.ws + WS_UT); run_gemm(shm, H, (const bf16_t*)(p.ws + WS_WHI), 3072, 1024, E); }
    } else {
        if (l == 0) attn_phase(p);
        else { for (int it = blockIdx.x; it < 128 + 256; it += gridDim.x) hyena_item(p, it, (LAS unsigned char*)shm); }
    }
}

__global__ __launch_bounds__(512, 2) void mega_fwd(Params p) {
    extern __shared__ __attribute__((aligned(16))) unsigned char shm[];
    cg::grid_group grid = cg::this_grid();
#define MK_PHASE(K) if (p.ph_lo <= (K) && (K) < p.ph_hi) { run_phase(p, (K), shm); if ((MK_DUP_MASK >> (K)) & 1u) { grid.sync(); run_phase(p, (K), shm); } if ((K) + 1 < p.ph_hi) grid.sync(); }
    MK_PHASE(0) MK_PHASE(1) MK_PHASE(2) MK_PHASE(3) MK_PHASE(4) MK_PHASE(5) MK_PHASE(6) MK_PHASE(7) MK_PHASE(8) MK_PHASE(9) MK_PHASE(10)
    MK_PHASE(11) MK_PHASE(12) MK_PHASE(13) MK_PHASE(14) MK_PHASE(15) MK_PHASE(16) MK_PHASE(17) MK_PHASE(18) MK_PHASE(19) MK_PHASE(20) MK_PHASE(21)
#undef MK_PHASE
}

extern "C" void kernel_launch(void* const* d_in, const int* in_sizes, int n_in, void* d_out, int out_size, void* d_ws, size_t ws_size, hipStream_t stream) {
    static int grid = 0;
    if (grid == 0) {
        if (n_in != 28 || ws_size < WS_END) { fprintf(stderr, "kernel_launch: need 28 inputs and %zu B of workspace (got %d, %zu)\n", (size_t)WS_END, n_in, ws_size); grid = -1; return; }
        int dev = 0, cus = 0, per_cu = 0;
        hipGetDevice(&dev);
        hipDeviceGetAttribute(&cus, hipDeviceAttributeMultiprocessorCount, dev);
        if (hipFuncSetAttribute((const void*)mega_fwd, hipFuncAttributeMaxDynamicSharedMemorySize, LDS_BYTES) != hipSuccess) { fprintf(stderr, "kernel_launch: hipFuncSetAttribute failed\n"); grid = -1; return; }
        hipOccupancyMaxActiveBlocksPerMultiprocessor(&per_cu, (const void*)mega_fwd, 512, LDS_BYTES);
        if (per_cu < 1) { fprintf(stderr, "kernel_launch: occupancy query says %d blocks per CU\n", per_cu); per_cu = 1; }
        (void)hipGetLastError();
        grid = cus;
    }
    if (grid < 0) return;
    if (hipMemsetAsync((unsigned char*)d_ws + WS_CTR, 0, 256, stream) != hipSuccess) { fprintf(stderr, "kernel_launch: memset failed\n"); return; }
    Params p{};
    for (int i = 0; i < 28; ++i) p.in[i] = (const float*)d_in[i];
    p.out = (float*)d_out; p.ws = (unsigned char*)d_ws;
#if MK_LAUNCHES == 1
    p.ph_lo = 0; p.ph_hi = N_PHASES;
    void* args[] = {&p};
    hipError_t e = hipLaunchCooperativeKernel((const void*)mega_fwd, dim3(grid), dim3(512), args, LDS_BYTES, stream);
    if (e != hipSuccess) fprintf(stderr, "cooperative launch failed: %s (grid %d)\n", hipGetErrorString(e), grid);
#else
    for (int ph = 0; ph < N_PHASES; ++ph) {
        p.ph_lo = ph; p.ph_hi = ph + 1;
        hipLaunchKernelGGL(mega_fwd, dim3(grid), dim3(512), LDS_BYTES, stream, p);
    }
#endif
}
```

```cpp
#include <hip/hip_runtime.h>
#include <hip/hip_cooperative_groups.h>
#include <cstdio>
#include <cstdint>
namespace cg = cooperative_groups;
#ifndef MK_LAUNCHES
#define MK_LAUNCHES 1
#endif
#ifndef MK_DUP_MASK
#define MK_DUP_MASK 0u
#endif
namespace pg8 {
#define PG8_LAS __attribute__((address_space(3)))
typedef unsigned short bf16_t;
typedef short bf16x8 __attribute__((ext_vector_type(8)));
typedef float f32x4 __attribute__((ext_vector_type(4)));
typedef unsigned u32x4 __attribute__((ext_vector_type(4)));
constexpr int BM = 256, BK = 64, HALF = 128, HTB = HALF * BK * 2  , STAGE_BYTES = 8 * HTB, NXCD = 8, WGM = 8;

__host__ __device__ __forceinline__ int lds_byte(int r, int c) { const int st = (r >> 4) * 2 + (c >> 5), rr = r & 15, cc = c & 31, ob = rr * 64 + cc * 2; return st * 1024 + (ob ^ (((ob >> 9) & 1) << 5)); }
__host__ __device__ __forceinline__ void stage_rc(int b, int& R, int& C) { const int st = b / 1024, sb = b % 1024, swz = sb ^ (((sb >> 9) & 1) << 5); R = (st >> 1) * 16 + swz / 64; C = (st & 1) * 32 + (swz % 64) / 2; }
__host__ __device__ __forceinline__ int perm32(int rho) { const int n = rho >> 4, i = rho & 15; return 8 * (i >> 2) + 4 * n + (i & 3); }

struct Unit { int pm, pn; };
struct Gemm { const bf16_t* A; const bf16_t* Bt; int M, N, K; };

struct StaticOrder {
    int nM, nN, nwg, G, c;
    __host__ __device__ void init(int M, int N, int G_, int c_) { nM = M / BM; nN = N / BM; nwg = nM * nN; G = G_; c = c_; }
    __host__ __device__ bool next(int i, Unit& u) const {
        const long L = (long)i * G + c; if (L >= nwg) return false;
        int wgid = (int)L; { const int q = nwg / NXCD, r = nwg % NXCD, xcd = wgid % NXCD, off = wgid / NXCD; wgid = (xcd < r ? xcd * (q + 1) : r * (q + 1) + (xcd - r) * q) + off; }
        const int nig = WGM * nN, gid = wgid / nig, fm = gid * WGM, gsz = (nM - fm) < WGM ? (nM - fm) : WGM;
        u.pm = fm + ((wgid % nig) % gsz); u.pn = (wgid % nig) / gsz; return true;
    }
    __device__ __forceinline__ void a_ready(const Unit&) const {}
    __device__ __forceinline__ void done(const Unit&) const {}
};
__device__ __forceinline__ unsigned cvt_pk_bf16(float lo, float hi) { unsigned r; asm volatile("v_cvt_pk_bf16_f32 %0, %1, %2" : "=v"(r) : "v"(lo), "v"(hi)); return r; }
typedef float f32x2 __attribute__((ext_vector_type(2)));
template <class Epi, class Sched, bool STAMP = false>
__device__ __forceinline__ void gemm_phase(PG8_LAS unsigned char* lds, const Gemm g, const Sched& S, const Epi& E, unsigned long long* stamps) {
    const int tid = threadIdx.x, wid = __builtin_amdgcn_readfirstlane(tid >> 6), lane = tid & 63, wr = wid >> 2, wc = wid & 3, fr = lane & 15, fq = lane >> 4;
    const int K = g.K, nt = K / BK;
    int ts_lo = 0, ts_hi = 0, nts = 0; const unsigned long long rt_entry = STAMP ? (unsigned long long)wall_clock64() : 0ull;
#define PG8_STAMP() do { if (STAMP && wid == 0 && nts < 64) { const unsigned long long _c = (unsigned long long)clock64(); \
        ts_lo = (lane == nts) ? (int)(unsigned)_c : ts_lo; ts_hi = (lane == nts) ? (int)(unsigned)(_c >> 32) : ts_hi; ++nts; } } while (0)
    PG8_STAMP();
    unsigned voffA[2], voffB[2];
#pragma unroll
    for (int i = 0; i < 2; ++i) { int R, C; stage_rc(tid * 16 + i * 8192, R, C); const int Rb = Epi::PERM ? ((R & ~31) + perm32(R & 31)) : R;
        voffA[i] = (unsigned)(R * K + C) * 2u; voffB[i] = (unsigned)(Rb * K + C) * 2u; }
    const size_t kstep = (size_t)(BK * 2);
    const size_t hstep = (size_t)HALF * K * 2;
    const size_t tstep = 2 * hstep;
    const unsigned ldsw = (unsigned)wid * 1024u;
    const int aoff = lds_byte(wr * 64 + fr, fq * 8), boff = lds_byte(wc * 32 + fr, fq * 8);
#define PG8_SA(b, h) (((b) * 2 + (h)) * HTB)
#define PG8_SB(b, h) ((4 + (b) * 2 + (h)) * HTB)
#define PG8_STAGE(bufoff, gbase, voff) do { _Pragma("unroll") for (int _i = 0; _i < 2; ++_i) \
        __builtin_amdgcn_global_load_lds((const unsigned*)((const char*)(gbase) + (voff)[_i]), (PG8_LAS unsigned*)(lds + (bufoff) + ldsw + _i * 8192), 16, 0, 0); } while (0)
#define PG8_LDA(dst, b, h) do { _Pragma("unroll") for (int m = 0; m < 4; ++m) _Pragma("unroll") for (int k = 0; k < 2; ++k) dst[m][k] = *(const PG8_LAS bf16x8*)(lds + PG8_SA(b, h) + aoff + m * 2048 + k * 1024); } while (0)
#define PG8_LDB(dst, b, h) do { _Pragma("unroll") for (int n = 0; n < 2; ++n) _Pragma("unroll") for (int k = 0; k < 2; ++k) dst[n][k] = *(const PG8_LAS bf16x8*)(lds + PG8_SB(b, h) + boff + n * 2048 + k * 1024); } while (0)
#define PG8_MMA(ai, bj, At, Bt) do { __builtin_amdgcn_s_setprio(1); _Pragma("unroll") for (int m = 0; m < 4; ++m) _Pragma("unroll") for (int n = 0; n < 2; ++n) _Pragma("unroll") for (int k = 0; k < 2; ++k) \
        acc[ai][bj][m][n] = __builtin_amdgcn_mfma_f32_16x16x32_bf16(Bt[n][k], At[m][k], acc[ai][bj][m][n], 0, 0, 0); __builtin_amdgcn_s_setprio(0); } while (0)
#define PG8_WAIT_V(n) asm volatile("s_waitcnt vmcnt(" #n ")" ::: "memory")
#define PG8_WAIT_L(n) asm volatile("s_waitcnt lgkmcnt(" #n ")" ::: "memory")
#define PG8_BAR __builtin_amdgcn_s_barrier()
#define PG8_SCHED __builtin_amdgcn_sched_barrier(0)
    Unit cur, nxt; int ui = 0;
    if (!S.next(0, cur)) return;
    f32x4 acc[2][2][4][2];
#pragma unroll
    for (int a = 0; a < 2; ++a)
#pragma unroll
        for (int b = 0; b < 2; ++b)
#pragma unroll
            for (int m = 0; m < 4; ++m)
#pragma unroll
                for (int n = 0; n < 2; ++n) acc[a][b][m][n] = (f32x4){0.f, 0.f, 0.f, 0.f};
    bf16x8 At[4][2], B0[2][2], B1[2][2];
    const char* cA = (const char*)g.A + (size_t)cur.pm * tstep; const char* cB = (const char*)g.Bt + (size_t)cur.pn * tstep;
    S.a_ready(cur);
    PG8_STAGE(PG8_SB(0, 0), cB, voffB); PG8_STAGE(PG8_SA(0, 0), cA, voffA); PG8_STAGE(PG8_SB(0, 1), cB + hstep, voffB); PG8_STAGE(PG8_SA(0, 1), cA + hstep, voffA);
    if (wr == 1) PG8_BAR;
    PG8_WAIT_V(4); PG8_BAR;
    PG8_STAGE(PG8_SB(1, 0), cB + kstep, voffB); PG8_STAGE(PG8_SA(1, 0), cA + kstep, voffA); PG8_STAGE(PG8_SB(1, 1), cB + hstep + kstep, voffB);
    PG8_WAIT_V(6); PG8_BAR;
    PG8_STAMP();
    for (;;) {
        const bool has_next = S.next(ui + 1, nxt);
        const char* nA = has_next ? (const char*)g.A + (size_t)nxt.pm * tstep : cA; const char* nB = has_next ? (const char*)g.Bt + (size_t)nxt.pn * tstep : cB;
        for (int t = 0; t < nt; t += 2) {
            const bool last = (t == nt - 2);
            const char* a1 = cA + (size_t)(t + 1) * kstep;
            const char* a2 = last ? nA : cA + (size_t)(t + 2) * kstep; const char* b2 = last ? nB : cB + (size_t)(t + 2) * kstep;
            const char* a3 = a2 + kstep; const char* b3 = b2 + kstep;
            if (last && has_next) S.a_ready(nxt);
            PG8_LDB(B0, 0, 0); PG8_SCHED; PG8_LDA(At, 0, 0); PG8_STAGE(PG8_SA(1, 1), a1 + hstep, voffA);
            PG8_WAIT_L(8); PG8_BAR; PG8_WAIT_L(0); PG8_MMA(0, 0, At, B0); PG8_BAR; PG8_SCHED;
            PG8_LDB(B1, 0, 1); PG8_STAGE(PG8_SB(0, 0), b2, voffB);
            PG8_BAR; PG8_WAIT_L(0); PG8_MMA(0, 1, At, B1); PG8_BAR;
            PG8_LDA(At, 0, 1); PG8_STAGE(PG8_SA(0, 0), a2, voffA);
            PG8_BAR; PG8_WAIT_L(0); PG8_MMA(1, 0, At, B0); PG8_BAR; PG8_SCHED;
            PG8_STAGE(PG8_SB(0, 1), b2 + hstep, voffB);
            PG8_WAIT_V(6); PG8_BAR; PG8_MMA(1, 1, At, B1); PG8_BAR;
            PG8_LDB(B0, 1, 0); PG8_SCHED; PG8_LDA(At, 1, 0); PG8_STAGE(PG8_SA(0, 1), a2 + hstep, voffA);
            PG8_WAIT_L(8); PG8_BAR; PG8_WAIT_L(0); PG8_MMA(0, 0, At, B0); PG8_BAR; PG8_SCHED;
            PG8_LDB(B1, 1, 1); PG8_STAGE(PG8_SB(1, 0), b3, voffB);
            PG8_BAR; PG8_WAIT_L(0); PG8_MMA(0, 1, At, B1); PG8_BAR;
            PG8_LDA(At, 1, 1); PG8_STAGE(PG8_SA(1, 0), a3, voffA);
            PG8_BAR; PG8_WAIT_L(0); PG8_MMA(1, 0, At, B0); PG8_BAR; PG8_SCHED;
            PG8_STAGE(PG8_SB(1, 1), b3 + hstep, voffB);
            PG8_WAIT_V(6); PG8_BAR; PG8_MMA(1, 1, At, B1); PG8_BAR;
        }
        PG8_STAMP();
        if constexpr (!Epi::AFTER_DRAIN) { E(acc, cur, wr, wc, fr, fq); S.done(cur); }
        PG8_STAMP();
        if (!has_next) break;
#pragma unroll
        for (int a = 0; a < 2; ++a)
#pragma unroll
            for (int b = 0; b < 2; ++b)
#pragma unroll
                for (int m = 0; m < 4; ++m)
#pragma unroll
                    for (int n = 0; n < 2; ++n) acc[a][b][m][n] = (f32x4){0.f, 0.f, 0.f, 0.f};
        cur = nxt; cA = nA; cB = nB; ++ui;
    }
    PG8_WAIT_V(0);
    if (wr == 0) PG8_BAR;
    PG8_BAR;
    if constexpr (Epi::AFTER_DRAIN) { E.fused(acc, cur, wr, wc, fr, fq, lds, wid, lane); S.done(cur); }
    PG8_STAMP();
    if (STAMP && wid == 0) { stamps[lane] = lane < nts ? (((unsigned long long)(unsigned)ts_hi << 32) | (unsigned)ts_lo) : 0ull;
        if (lane == 62) stamps[62] = rt_entry; if (lane == 63) stamps[63] = (unsigned long long)wall_clock64(); }
#undef PG8_STAMP
#undef PG8_SA
#undef PG8_SB
#undef PG8_STAGE
#undef PG8_LDA
#undef PG8_LDB
#undef PG8_MMA
#undef PG8_WAIT_V
#undef PG8_WAIT_L
#undef PG8_BAR
#undef PG8_SCHED
}
}
using pg8::bf16_t; using pg8::bf16x8; using pg8::f32x4; using pg8::u32x4; using pg8::cvt_pk_bf16; using pg8::Unit;
#define LAS __attribute__((address_space(3)))
typedef float f32x16 __attribute__((ext_vector_type(16)));
typedef unsigned u32x2 __attribute__((ext_vector_type(2)));

constexpr int D = 1024, DFF = 2816, NTOK = 12288, NCTX = 8192;
constexpr float ALPHA = 1.4142135623730951f;
constexpr float LN_EPS = 1e-5f;
constexpr int GS_LAT = 2 * 2048 + 32, GS_CTX = 2 * 256 + 32;

constexpr size_t SZ_WFI = (size_t)5632 * 1024 * 2, SZ_WFO = (size_t)1024 * 2816 * 2;
constexpr size_t WS_WFI = 0;
constexpr size_t WS_WFO = WS_WFI + 4 * SZ_WFI;
constexpr size_t WS_WQKV = WS_WFO + 4 * SZ_WFO;
constexpr size_t WS_WO = WS_WQKV + (size_t)3072 * 1024 * 2;
constexpr size_t WS_WHI = WS_WO + (size_t)1024 * 1024 * 2;
constexpr size_t WS_WHO = WS_WHI + (size_t)3072 * 1024 * 2;
constexpr size_t WS_MOD = WS_WHO + (size_t)1024 * 1024 * 2;
constexpr size_t WS_HID = WS_MOD + (size_t)2 * 3 * 9216 * 4;
constexpr size_t WS_KC = WS_HID + (size_t)(2048 + 256) * 64 * 4;
constexpr size_t WS_VCT = WS_KC + (size_t)2 * 256 * 1024 * 2;
constexpr size_t WS_GLAT = WS_VCT + (size_t)2 * 256 * 1024 * 2;
constexpr size_t WS_GCTX = WS_GLAT + (size_t)2 * 1024 * GS_LAT * 2;
constexpr size_t WS_X = WS_GCTX + (size_t)2 * 1024 * GS_CTX * 2;
constexpr size_t WS_Y = WS_X + (size_t)NTOK * D * 4;
constexpr size_t WS_H = WS_Y + (size_t)NTOK * D * 4;
constexpr size_t WS_M = WS_H + (size_t)NTOK * D * 2;
constexpr size_t WS_ACT = WS_M;
constexpr size_t WS_Q = WS_M;
constexpr size_t WS_K = WS_Q + (size_t)NTOK * D * 2;
constexpr size_t WS_VT = WS_K + (size_t)NTOK * D * 2;
constexpr size_t WS_UT = WS_M;
constexpr size_t WS_O = WS_M + (size_t)NTOK * 3072 * 2;
constexpr size_t WS_CTR = WS_O + (size_t)NTOK * D * 2;
constexpr size_t WS_END = WS_CTR + 256;
constexpr int LDS_BYTES = 81920 + 8 * 8256;

struct Params { const float* in[28]; float* out; unsigned char* ws; int ph_lo, ph_hi; };

__device__ __forceinline__ float bf2f(bf16_t b) { return __uint_as_float(((unsigned)b) << 16); }
__device__ __forceinline__ float bflo(unsigned w) { return __uint_as_float(w << 16); }
__device__ __forceinline__ float bfhi(unsigned w) { return __uint_as_float(w & 0xffff0000u); }
__device__ __forceinline__ bf16_t f2bf(float f) { return (bf16_t)(cvt_pk_bf16(f, 0.f) & 0xffffu); }
__device__ __forceinline__ float silu_f(float g) { return g * __builtin_amdgcn_rcpf(1.0f + __expf(-g)); }
__device__ __forceinline__ bf16x8 as_bf16x8(u32x4 v) { union { u32x4 u; bf16x8 b; } x; x.u = v; return x.b; }

struct EpiSwiglu {
    static constexpr bool PERM = true, AFTER_DRAIN = false;
    bf16_t* O;
    __device__ __forceinline__ void operator()(const f32x4 (&acc)[2][2][4][2], const Unit& u, int wr, int wc, int fr, int fq) const {
        const int row0 = u.pm * 256 + wr * 64 + fr, col0 = u.pn * 128 + wc * 32 + 8 * fq;
#pragma unroll
        for (int ai = 0; ai < 2; ++ai)
#pragma unroll
            for (int m = 0; m < 4; ++m) {
                bf16_t* rowp = O + (size_t)(row0 + ai * 128 + m * 16) * DFF + col0;
                const f32x4 g0 = acc[ai][0][m][0], g1 = acc[ai][0][m][1], u0 = acc[ai][1][m][0], u1 = acc[ai][1][m][1];
                u32x4 w;
                w.x = cvt_pk_bf16(silu_f(g0[0]) * u0[0], silu_f(g0[1]) * u0[1]); w.y = cvt_pk_bf16(silu_f(g0[2]) * u0[2], silu_f(g0[3]) * u0[3]);
                w.z = cvt_pk_bf16(silu_f(g1[0]) * u1[0], silu_f(g1[1]) * u1[1]); w.w = cvt_pk_bf16(silu_f(g1[2]) * u1[2], silu_f(g1[3]) * u1[3]);
                *(u32x4*)rowp = w;
            }
    }
};
struct EpiResid {
    static constexpr bool PERM = false, AFTER_DRAIN = false;
    const float* xa; const float* xb; float* Y; const float* modl; int gidx; float gscale;
    __device__ __forceinline__ void operator()(const f32x4 (&acc)[2][2][4][2], const Unit& u, int wr, int wc, int fr, int fq) const {
        const int row0 = u.pm * 256 + wr * 64 + fr, col0 = u.pn * 256 + wc * 32 + 4 * fq;
        const int ci = u.pm < 32 ? 0 : (u.pm < 40 ? 1 : 2);
        const float* gate = modl + ci * 9216 + gidx * 1024 + col0;
        f32x4 gv[2][2];
#pragma unroll
        for (int bj = 0; bj < 2; ++bj)
#pragma unroll
            for (int n = 0; n < 2; ++n) gv[bj][n] = *(const f32x4*)(gate + bj * 128 + n * 16) * gscale;
#pragma unroll
        for (int ai = 0; ai < 2; ++ai)
#pragma unroll
            for (int m = 0; m < 4; ++m) {
                const int row = row0 + ai * 128 + m * 16;
                const float* xr = (row < NCTX ? xa + (size_t)row * D : xb + (size_t)(row - NCTX) * D) + col0;
                float* yr = Y + (size_t)row * D + col0;
#pragma unroll
                for (int bj = 0; bj < 2; ++bj)
#pragma unroll
                    for (int n = 0; n < 2; ++n) { const f32x4 xv = *(const f32x4*)(xr + bj * 128 + n * 16); *(f32x4*)(yr + bj * 128 + n * 16) = xv * ALPHA + gv[bj][n] * acc[ai][bj][m][n]; }
            }
    }
};
__device__ __forceinline__ void store_T(const f32x4 (&acc)[2][2][4][2], const Unit& u, int wr, int wc, int fr, int fq, bf16_t* T, int C, int colt) {
    const bool lat = u.pm >= 32;
    const int L = lat ? 2048 : 256;
    const int row0 = u.pm * 256 + wr * 64 + fr;
#pragma unroll
    for (int ai = 0; ai < 2; ++ai)
#pragma unroll
        for (int m = 0; m < 4; ++m) {
            const int row = row0 + ai * 128 + m * 16;
            const int rr = lat ? row - NCTX : row;
            const int seq = lat ? (rr >> 11) : (rr >> 8), t = lat ? (rr & 2047) : (rr & 255);
            bf16_t* base = T + (lat ? (size_t)NCTX * C : (size_t)0) + (size_t)seq * C * L + t;
#pragma unroll
            for (int bj = 0; bj < 2; ++bj)
#pragma unroll
                for (int n = 0; n < 2; ++n)
#pragma unroll
                    for (int j = 0; j < 4; ++j) { const int col = colt + bj * 128 + wc * 32 + 8 * fq + 4 * n + j; base[(size_t)col * L] = f2bf(acc[ai][bj][m][n][j]); }
        }
}
struct EpiQKV {
    static constexpr bool PERM = true, AFTER_DRAIN = false;
    bf16_t* Q; bf16_t* Kb; bf16_t* Vt; float* outk; float* outv;
    __device__ __forceinline__ void operator()(const f32x4 (&acc)[2][2][4][2], const Unit& u, int wr, int wc, int fr, int fq) const {
        const int sel = u.pn >> 2, colt = (u.pn & 3) * 256;
        const int row0 = u.pm * 256 + wr * 64 + fr, col0 = colt + wc * 32 + 8 * fq;
        if (sel == 2) store_T(acc, u, wr, wc, fr, fq, Vt, 1024, colt);
#pragma unroll
        for (int ai = 0; ai < 2; ++ai)
#pragma unroll
            for (int m = 0; m < 4; ++m) {
                const int row = row0 + ai * 128 + m * 16;
#pragma unroll
                for (int bj = 0; bj < 2; ++bj) {
                    const f32x4 v0 = acc[ai][bj][m][0], v1 = acc[ai][bj][m][1];
                    const size_t off = (size_t)row * D + col0 + bj * 128;
                    if (sel == 0) { u32x4 w; w.x = cvt_pk_bf16(v0[0] * 0.125f, v0[1] * 0.125f); w.y = cvt_pk_bf16(v0[2] * 0.125f, v0[3] * 0.125f); w.z = cvt_pk_bf16(v1[0] * 0.125f, v1[1] * 0.125f); w.w = cvt_pk_bf16(v1[2] * 0.125f, v1[3] * 0.125f); *(u32x4*)(Q + off) = w; }
                    else if (sel == 1) { u32x4 w; w.x = cvt_pk_bf16(v0[0], v0[1]); w.y = cvt_pk_bf16(v0[2], v0[3]); w.z = cvt_pk_bf16(v1[0], v1[1]); w.w = cvt_pk_bf16(v1[2], v1[3]); *(u32x4*)(Kb + off) = w;
                        if (row < NCTX) { *(f32x4*)(outk + off) = v0; *(f32x4*)(outk + off + 4) = v1; } }
                    else { if (row < NCTX) { *(f32x4*)(outv + off) = v0; *(f32x4*)(outv + off + 4) = v1; } }
                }
            }
    }
};
struct EpiHyIn {
    static constexpr bool PERM = true, AFTER_DRAIN = false;
    bf16_t* Ut;
    __device__ __forceinline__ void operator()(const f32x4 (&acc)[2][2][4][2], const Unit& u, int wr, int wc, int fr, int fq) const {
        store_T(acc, u, wr, wc, fr, fq, Ut, 3072, u.pn * 256);
    }
};

template <class Epi>
__device__ __forceinline__ void run_gemm(unsigned char* shm, const bf16_t* A, const bf16_t* Bt, int N, int K, const Epi& E) {
    pg8::Gemm g; g.A = A; g.Bt = Bt; g.M = NTOK; g.N = N; g.K = K;
    pg8::StaticOrder S; S.init(NTOK, N, (int)gridDim.x, (int)blockIdx.x);
    pg8::gemm_phase<Epi, pg8::StaticOrder, false>((PG8_LAS unsigned char*)shm, g, S, E, nullptr);
}

__device__ __forceinline__ int take_ticket(unsigned* ctr, int lane) {
    unsigned t = 0;
    if (lane == 0) t = __hip_atomic_fetch_add(ctr, 1u, __ATOMIC_RELAXED, __HIP_MEMORY_SCOPE_AGENT);
    return (int)__builtin_amdgcn_readfirstlane(t);
}
__device__ __forceinline__ float wave_sum(float v) {
#pragma unroll
    for (int o = 1; o < 64; o <<= 1) v += __shfl_xor(v, o);
    return v;
}
__device__ __forceinline__ void mod_block(const Params& p, int l, int n0, const LAS float* sc, LAS float* red) {
    const int tid = threadIdx.x, wid = tid >> 6, lane = tid & 63, kg = lane >> 5, col = lane & 31;
    const int k0 = wid * 128 + kg * 64;
    const float* w = p.in[6] + (size_t)l * 1024 * 9216 + (size_t)k0 * 9216 + n0 + col;
    float a0 = 0.f, a1 = 0.f, a2 = 0.f;
#pragma unroll 32
    for (int k = 0; k < 64; ++k) { const float wv = w[(size_t)k * 9216]; a0 += sc[k0 + k] * wv; a1 += sc[1024 + k0 + k] * wv; a2 += sc[2048 + k0 + k] * wv; }
    a0 += __shfl_xor(a0, 32); a1 += __shfl_xor(a1, 32); a2 += __shfl_xor(a2, 32);
    if (lane < 32) { red[(wid * 3 + 0) * 32 + col] = a0; red[(wid * 3 + 1) * 32 + col] = a1; red[(wid * 3 + 2) * 32 + col] = a2; }
    __syncthreads();
    if (tid < 96) { const int ci = tid >> 5, c2 = tid & 31; float s = p.in[7][l * 9216 + n0 + c2];
#pragma unroll
        for (int g = 0; g < 8; ++g) s += red[(g * 3 + ci) * 32 + c2];
        ((float*)(p.ws + WS_MOD))[(size_t)(l * 3 + ci) * 9216 + n0 + c2] = s; }
    __syncthreads();
}
__device__ __forceinline__ void hid_wave(const Params& p, int r, LAS float* scr, int lane) {
    const bool lat = r < 512;
    const int L = lat ? 2048 : 256, pos0 = (lat ? r : r - 512) * 4;
    LAS float* zf = scr; LAS float* h1 = scr + 160;
    for (int idx = lane; idx < 132; idx += 64) {
        const int pp = idx / 33, j = idx - pp * 33, pos = pos0 + pp;
        float v;
        if (j == 0) v = (float)pos / (float)(L - 1);
        else { const int bi = (j - 1) & 15; const float band = 1e-4f + (float)bi * ((15.0f - 1e-4f) / 15.0f);
            const float rev = __builtin_amdgcn_fractf(((float)pos / (float)L) * band);
            v = j <= 16 ? __builtin_amdgcn_cosf(rev) : -__builtin_amdgcn_sinf(rev); }
        zf[idx] = v;
    }
    const int j = lane;
    float a[4]; { const float b = p.in[19][j]; a[0] = a[1] = a[2] = a[3] = b; }
#pragma unroll 11
    for (int i = 0; i < 33; ++i) { const float w = p.in[18][i * 64 + j]; a[0] += zf[i] * w; a[1] += zf[33 + i] * w; a[2] += zf[66 + i] * w; a[3] += zf[99 + i] * w; }
    { const float f = p.in[20][j] * 0.15915494309189535f;
#pragma unroll
        for (int pp = 0; pp < 4; ++pp) h1[pp * 64 + j] = __builtin_amdgcn_sinf(__builtin_amdgcn_fractf(a[pp] * f)); }
    float b[4]; { const float bb = p.in[22][j]; b[0] = b[1] = b[2] = b[3] = bb; }
#pragma unroll 16
    for (int i = 0; i < 64; ++i) { const float w = p.in[21][i * 64 + j]; b[0] += h1[i] * w; b[1] += h1[64 + i] * w; b[2] += h1[128 + i] * w; b[3] += h1[192 + i] * w; }
    float* hid = (float*)(p.ws + WS_HID) + (lat ? 0 : 2048 * 64);
    { const float f = p.in[23][j] * 0.15915494309189535f;
#pragma unroll
        for (int pp = 0; pp < 4; ++pp) hid[(pos0 + pp) * 64 + j] = __builtin_amdgcn_sinf(__builtin_amdgcn_fractf(b[pp] * f)); }
}
__device__ __forceinline__ void transpose_wave(const Params& p, int r, LAS float* tile, int lane) {
    const float* W; bf16_t* WT; int K, N, perm = 0;
    if (r < 5632) { const int mi = r / 1408; r %= 1408; W = p.in[10] + (size_t)mi * 1024 * 5632; WT = (bf16_t*)(p.ws + WS_WFI + mi * SZ_WFI); K = 1024; N = 5632; perm = 1; }
    else if ((r -= 5632) < 2816) { const int mi = r / 704; r %= 704; W = p.in[11] + (size_t)mi * 2816 * 1024; WT = (bf16_t*)(p.ws + WS_WFO + mi * SZ_WFO); K = 2816; N = 1024; }
    else if ((r -= 2816) < 768) { W = p.in[12]; WT = (bf16_t*)(p.ws + WS_WQKV); K = 1024; N = 3072; }
    else if ((r -= 768) < 256) { W = p.in[13]; WT = (bf16_t*)(p.ws + WS_WO); K = 1024; N = 1024; }
    else if ((r -= 256) < 768) { W = p.in[15]; WT = (bf16_t*)(p.ws + WS_WHI); K = 1024; N = 3072; }
    else { r -= 768; W = p.in[27]; WT = (bf16_t*)(p.ws + WS_WHO); K = 1024; N = 1024; }
    const int ntn = N / 64, k0 = (r / ntn) * 64, n0 = (r % ntn) * 64;
    int nd0 = n0;
    if (perm) { const int hf = n0 >= DFF, nn = hf ? n0 - DFF : n0; nd0 = (nn >> 7) * 256 + hf * 128 + (nn & 127); }
    const int lr = lane >> 4, lc = (lane & 15) * 4;
    const float* src = W + (size_t)(k0 + lr) * N + n0 + lc;
    f32x4 v[16];
#pragma unroll
    for (int i = 0; i < 16; ++i) v[i] = *(const f32x4*)(src + (size_t)(4 * i) * N);
#pragma unroll
    for (int i = 0; i < 16; ++i) { LAS float* t = tile + (4 * i + lr) * 65 + lc; t[0] = v[i][0]; t[1] = v[i][1]; t[2] = v[i][2]; t[3] = v[i][3]; }
    const int ch = lane & 7;
#pragma unroll
    for (int j = 0; j < 8; ++j) { const int n = (lane >> 3) + 8 * j; const LAS float* s = tile + (8 * ch) * 65 + n;
        u32x4 o; o.x = cvt_pk_bf16(s[0], s[65]); o.y = cvt_pk_bf16(s[2 * 65], s[3 * 65]); o.z = cvt_pk_bf16(s[4 * 65], s[5 * 65]); o.w = cvt_pk_bf16(s[6 * 65], s[7 * 65]);
        *(u32x4*)(WT + (size_t)(nd0 + n) * K + k0 + 8 * ch) = o; }
}
constexpr int P0_HID = 576, P0_KC = 128, P0_VC = 128, P0_TR = 10496, P0_TOTAL = P0_HID + P0_KC + P0_VC + P0_TR;
__device__ __forceinline__ void p0_phase(const Params& p, unsigned char* shm, int dup) {
    const int tid = threadIdx.x, wid = tid >> 6, lane = tid & 63;
    LAS float* sc = (LAS float*)(LAS unsigned char*)shm;
    LAS float* tile = (LAS float*)((LAS unsigned char*)shm + 12288 + wid * 16640);
    for (int i = tid; i < 3072; i += 512) { const int ci = i >> 10, k = i & 1023; const float v = ci == 0 ? p.in[5][k] : p.in[4][(ci - 1) * 1024 + k]; sc[i] = v / (1.0f + __expf(-v)); }
    __syncthreads();
    for (int it = blockIdx.x; it < 64; it += gridDim.x) mod_block(p, 0, it * 32, sc, (LAS float*)((LAS unsigned char*)shm + 12288));
    const int gw = wid * gridDim.x + blockIdx.x, ngw = 8 * gridDim.x;
    for (int it = gw; it < P0_TOTAL; it += ngw) {
        int r = it;
        if (r < P0_HID) hid_wave(p, r, tile, lane);
        else if ((r -= P0_HID) < P0_KC) {
#pragma unroll
            for (int j = 0; j < 8; ++j) { const size_t e = ((size_t)r * 512 + j * 64 + lane) * 8; const f32x4 a = *(const f32x4*)(p.in[2] + e), b = *(const f32x4*)(p.in[2] + e + 4);
                u32x4 o; o.x = cvt_pk_bf16(a[0], a[1]); o.y = cvt_pk_bf16(a[2], a[3]); o.z = cvt_pk_bf16(b[0], b[1]); o.w = cvt_pk_bf16(b[2], b[3]);
                *(u32x4*)((bf16_t*)(p.ws + WS_KC) + e) = o; } }
        else if ((r -= P0_KC) < P0_VC) {
            for (int j = 0; j < 8; ++j) { const int g = r * 512 + j * 64 + lane;
                const int t = g & 255, c8 = (g >> 8) & 127, b = g >> 15;
                const float* src = p.in[3] + ((size_t)(b * 256 + t)) * 1024 + c8 * 8;
                const f32x4 a = *(const f32x4*)src, bb = *(const f32x4*)(src + 4);
                bf16_t* dst = (bf16_t*)(p.ws + WS_VCT) + ((size_t)b * 1024 + c8 * 8) * 256 + t;
                dst[0] = f2bf(a[0]); dst[256] = f2bf(a[1]); dst[512] = f2bf(a[2]); dst[768] = f2bf(a[3]);
                dst[1024] = f2bf(bb[0]); dst[1280] = f2bf(bb[1]); dst[1536] = f2bf(bb[2]); dst[1792] = f2bf(bb[3]); } }
        else { r -= P0_VC; transpose_wave(p, r, tile, lane); }
    }
}

__device__ __forceinline__ void row_do(const Params& p, int mode, int row, const float* Ysrc, float* Xout, const float* lng, const float* lnb, const float* modl, int shidx, int lane) {
    bf16_t* H = (bf16_t*)(p.ws + WS_H);
    const float* src = mode == 0 ? (row < NCTX ? p.in[0] + (size_t)row * D : p.in[1] + (size_t)(row - NCTX) * D) : Ysrc + (size_t)row * D;
    f32x4 v[4];
#pragma unroll
    for (int j = 0; j < 4; ++j) v[j] = *(const f32x4*)(src + lane * 4 + 256 * j);
    if (mode != 0) {
        float s = 0.f;
#pragma unroll
        for (int j = 0; j < 4; ++j) s += (v[j][0] + v[j][1]) + (v[j][2] + v[j][3]);
        const float mean = wave_sum(s) * (1.0f / D);
        float s2 = 0.f;
#pragma unroll
        for (int j = 0; j < 4; ++j) { v[j] = v[j] - mean; s2 += (v[j][0] * v[j][0] + v[j][1] * v[j][1]) + (v[j][2] * v[j][2] + v[j][3] * v[j][3]); }
        const float rstd = 1.0f / sqrtf(wave_sum(s2) * (1.0f / D) + LN_EPS);
#pragma unroll
        for (int j = 0; j < 4; ++j) { const f32x4 g = *(const f32x4*)(lng + lane * 4 + 256 * j), b = *(const f32x4*)(lnb + lane * 4 + 256 * j);
            v[j] = v[j] * rstd * g + b; *(f32x4*)(Xout + (size_t)row * D + lane * 4 + 256 * j) = v[j]; }
    }
    if (mode != 2) {
        const int ci = row < NCTX ? 0 : (row < NCTX + 2048 ? 1 : 2);
        const float* sh = modl + ci * 9216 + shidx * 1024, *scp = sh + 1024;
#pragma unroll
        for (int j = 0; j < 4; ++j) { const f32x4 a = *(const f32x4*)(sh + lane * 4 + 256 * j), s = *(const f32x4*)(scp + lane * 4 + 256 * j);
            const f32x4 h = v[j] * (s + 1.0f) + a; u32x2 w; w.x = cvt_pk_bf16(h[0], h[1]); w.y = cvt_pk_bf16(h[2], h[3]);
            *(u32x2*)(H + (size_t)row * D + lane * 4 + 256 * j) = w; }
    }
}
__device__ __forceinline__ void row_phase(const Params& p, int mode, const float* Ysrc, float* Xout, const float* lng, const float* lnb, const float* modl, int shidx) {
    const int lane = threadIdx.x & 63, gw = blockIdx.x * 8 + (threadIdx.x >> 6), ngw = gridDim.x * 8;
    for (int row = gw; row < NTOK; row += ngw) row_do(p, mode, row, Ysrc, Xout, lng, lnb, modl, shidx, lane);
}

__device__ __forceinline__ void gimg_wave(const Params& p, int job, int lane) {
    const int nblk = job >> 4, pch = job & 15, n0 = nblk * 32, o = n0 >> 11, dir = (n0 >> 10) & 1, nl = lane & 31, h = lane >> 5;
    const int c = (n0 & 1023) + nl;
    const float* w3 = p.in[24] + (size_t)(32 * h) * 4096 + n0 + nl;
    float bw[32];
#pragma unroll
    for (int kk = 0; kk < 32; ++kk) bw[kk] = w3[(size_t)kk * 4096];
    const float b3v = p.in[25][n0 + nl], hbv = p.in[26][o * 1024 + c];
    const float da = -3.0701134573253943f, db = -15.350567286626972f;
    const float delta = fabsf(da + (float)c * ((db - da) / 1023.0f));
    const int nblkj = (pch & 1) ? 4 : 5;
#pragma unroll 1
    for (int blk = 0; blk < nblkj; ++blk) {
        const bool lat = blk < 4;
        const int L = lat ? 2048 : 256, GS = 2 * L + 32, pos0 = lat ? (pch * 4 + blk) * 32 : (pch >> 1) * 32;
        const float* hrow = (const float*)(p.ws + WS_HID) + (lat ? 0 : 2048 * 64) + (size_t)(pos0 + nl) * 64 + 32 * h;
        f32x4 af[8];
#pragma unroll
        for (int i = 0; i < 8; ++i) af[i] = *(const f32x4*)(hrow + 4 * i);
        f32x16 acc;
#pragma unroll
        for (int j = 0; j < 16; ++j) acc[j] = 0.f;
#pragma unroll
        for (int kk = 0; kk < 32; ++kk) acc = __builtin_amdgcn_mfma_f32_32x32x2f32(af[kk >> 2][kk & 3], bw[kk], acc, 0, 0, 0);
        bf16_t* im = (bf16_t*)(p.ws + (lat ? WS_GLAT : WS_GCTX)) + (size_t)(o * 1024 + c) * GS;
        const float tsc = -delta / (float)(L - 1);
#pragma unroll
        for (int rg = 0; rg < 4; ++rg) {
            const int q0 = pos0 + 8 * rg + 4 * h;
            float v[4];
#pragma unroll
            for (int j = 0; j < 4; ++j) v[j] = (acc[4 * rg + j] + b3v) * __expf((float)(q0 + j) * tsc);
            if (dir == 0) {
                if (q0 == 0) v[0] += hbv;
                im[L - q0] = f2bf(v[0]); *(unsigned*)(im + L - q0 - 2) = cvt_pk_bf16(v[2], v[1]); im[L - q0 - 3] = f2bf(v[3]);
            } else {
                if (q0 == 0) { im[L + 1] = f2bf(v[1]); *(unsigned*)(im + L + 2) = cvt_pk_bf16(v[2], v[3]); }
                else { u32x2 w; w.x = cvt_pk_bf16(v[0], v[1]); w.y = cvt_pk_bf16(v[2], v[3]); *(u32x2*)(im + L + q0) = w; }
            }
        }
        if (dir == 1) {
            const bool last = lat ? (pch == 15 && blk == 3) : (pch == 14);
            if (last) { const u32x4 z = {0u, 0u, 0u, 0u}; *(u32x4*)(im + 2 * L + 16 * h) = z; *(u32x4*)(im + 2 * L + 16 * h + 8) = z; }
            if (pos0 == 0 && h == 0) im[0] = 0;
        }
    }
}
__device__ __forceinline__ void p1_phase(const Params& p, unsigned char* shm, int dup) {
    const int tid = threadIdx.x, wid = tid >> 6, lane = tid & 63;
    LAS float* sc = (LAS float*)(LAS unsigned char*)shm;
    for (int i = tid; i < 3072; i += 512) { const int ci = i >> 10, k = i & 1023; const float v = ci == 0 ? p.in[5][k] : p.in[4][(ci - 1) * 1024 + k]; sc[i] = v / (1.0f + __expf(-v)); }
    __syncthreads();
    for (int it = blockIdx.x; it < 512; it += gridDim.x) { const int cc = it + 64; mod_block(p, cc / 288, (cc % 288) * 32, sc, (LAS float*)((LAS unsigned char*)shm + 12288)); }
    const int gw = wid * gridDim.x + blockIdx.x, ngw = 8 * gridDim.x;
    for (int it = gw; it < 2048; it += ngw) gimg_wave(p, it, lane);
    for (int it = gw; it < 2048; it += ngw)
        for (int j = 0; j < 6; ++j) row_do(p, 0, it * 6 + j, nullptr, nullptr, nullptr, nullptr, (const float*)(p.ws + WS_MOD), 0, lane);
}

struct AttnArgs { const bf16_t *Q, *K, *Vt, *Kc, *Vct; const float* rpb; bf16_t* O; };
template <bool LAT>
__device__ __forceinline__ void attn_wave(const AttnArgs& A, int b, int h, int qrow0, int r, int n, int lane) {
    constexpr int NKB = LAT ? 32 : 16;
    const int fr = lane & 15, fq = lane >> 4;
    const bf16_t* qp = A.Q + (size_t)(qrow0 + fr) * D + h * 64 + 8 * fq;
    const bf16x8 q0 = *(const bf16x8*)qp, q1 = *(const bf16x8*)(qp + 32);
    int rs = 0, kstart = 0;
    if (LAT) { rs = min(max(r - 4, 0), 24); kstart = n == 0 ? 0 : (n == 1 ? 8 : (n == 2 ? 24 : 32)); }
    f32x4 s[NKB];
#pragma unroll
    for (int kb = 0; kb < NKB; ++kb) {
        const bf16_t* kp;
        if (LAT && kb < 16) kp = A.K + (size_t)(NCTX + b * 2048 + (rs + (kb >> 1)) * 64 + kstart + (kb & 1) * 16 + fr) * D;
        else if (LAT) kp = A.Kc + (size_t)(b * 256 + (kb - 16) * 16 + fr) * D;
        else kp = A.K + (size_t)(b * 256 + kb * 16 + fr) * D;
        kp += h * 64 + 8 * fq;
        const bf16x8 a0 = *(const bf16x8*)kp, a1 = *(const bf16x8*)(kp + 32);
        f32x4 z = {0.f, 0.f, 0.f, 0.f};
        z = __builtin_amdgcn_mfma_f32_16x16x32_bf16(a0, q0, z, 0, 0, 0);
        z = __builtin_amdgcn_mfma_f32_16x16x32_bf16(a1, q1, z, 0, 0, 0);
        s[kb] = z;
    }
    if (LAT) {
        const int qcol = n * 16 + fr, cstart = min(max(qcol - 8, 0), 48);
#pragma unroll
        for (int kb = 0; kb < 16; ++kb) {
            const int drow = rs + (kb >> 1) - r + 7;
            const float* bp = A.rpb + h * 465 + drow * 31;
#pragma unroll
            for (int i = 0; i < 4; ++i) {
                const int kc = kstart + (kb & 1) * 16 + 4 * fq + i;
                const bool ok = kc >= cstart && kc < cstart + 16;
                const int dcol = min(max(kc - qcol, -15), 15) + 15;
                const float bias = bp[dcol];
                s[kb][i] = ok ? s[kb][i] + bias : -INFINITY;
            }
        }
    }
    float mx = -INFINITY;
#pragma unroll
    for (int kb = 0; kb < NKB; ++kb) mx = fmaxf(fmaxf(fmaxf(s[kb][0], s[kb][1]), fmaxf(s[kb][2], s[kb][3])), mx);
    mx = fmaxf(mx, __shfl_xor(mx, 16)); mx = fmaxf(mx, __shfl_xor(mx, 32));
    float sum = 0.f;
#pragma unroll
    for (int kb = 0; kb < NKB; ++kb)
#pragma unroll
        for (int i = 0; i < 4; ++i) { const float e = __expf(s[kb][i] - mx); s[kb][i] = e; sum += e; }
    sum += __shfl_xor(sum, 16); sum += __shfl_xor(sum, 32);
    const float inv = 1.0f / sum;
    f32x4 o[4];
#pragma unroll
    for (int db = 0; db < 4; ++db) o[db] = (f32x4){0.f, 0.f, 0.f, 0.f};
#pragma unroll
    for (int pp = 0; pp < NKB / 2; ++pp) {
        u32x4 pw; pw.x = cvt_pk_bf16(s[2 * pp][0], s[2 * pp][1]); pw.y = cvt_pk_bf16(s[2 * pp][2], s[2 * pp][3]);
        pw.z = cvt_pk_bf16(s[2 * pp + 1][0], s[2 * pp + 1][1]); pw.w = cvt_pk_bf16(s[2 * pp + 1][2], s[2 * pp + 1][3]);
        const bf16x8 pf = as_bf16x8(pw);
#pragma unroll
        for (int db = 0; db < 4; ++db) {
            const int col = h * 64 + 16 * db + fr;
            const bf16_t* vp;
            if (LAT && pp < 8) vp = A.Vt + (size_t)NCTX * 1024 + (size_t)b * (1024 * 2048) + (size_t)col * 2048 + (rs + pp) * 64 + kstart + 4 * fq;
            else if (LAT) vp = A.Vct + (size_t)b * (1024 * 256) + col * 256 + (pp - 8) * 32 + 4 * fq;
            else vp = A.Vt + (size_t)b * (1024 * 256) + col * 256 + pp * 32 + 4 * fq;
            const u32x2 v0 = *(const u32x2*)vp, v1 = *(const u32x2*)(vp + 16);
            u32x4 vw; vw.x = v0.x; vw.y = v0.y; vw.z = v1.x; vw.w = v1.y;
            o[db] = __builtin_amdgcn_mfma_f32_16x16x32_bf16(as_bf16x8(vw), pf, o[db], 0, 0, 0);
        }
    }
    bf16_t* op = A.O + (size_t)(qrow0 + fr) * D + h * 64 + 4 * fq;
#pragma unroll
    for (int db = 0; db < 4; ++db) { u32x2 w; w.x = cvt_pk_bf16(o[db][0] * inv, o[db][1] * inv); w.y = cvt_pk_bf16(o[db][2] * inv, o[db][3] * inv); *(u32x2*)(op + 16 * db) = w; }
}
__device__ __forceinline__ void attn_phase(const Params& p) {
    AttnArgs A; A.Q = (const bf16_t*)(p.ws + WS_Q); A.K = (const bf16_t*)(p.ws + WS_K); A.Vt = (const bf16_t*)(p.ws + WS_VT);
    A.Kc = (const bf16_t*)(p.ws + WS_KC); A.Vct = (const bf16_t*)(p.ws + WS_VCT); A.rpb = p.in[14]; A.O = (bf16_t*)(p.ws + WS_O);
    const int w = threadIdx.x >> 6, lane = threadIdx.x & 63;
    for (int it = blockIdx.x; it < 512 + 1024; it += gridDim.x) {
        if (it < 512) { const int b = it >> 8, r = (it >> 3) & 31, h = (it & 7) * 2 + (w >> 2), n = w & 3;
            attn_wave<true>(A, b, h, NCTX + b * 2048 + r * 64 + n * 16, r, n, lane); }
        else { const int i2 = it - 512; const int b = i2 >> 5, h = (i2 >> 1) & 15, qc = (i2 & 1) * 8 + w;
            attn_wave<false>(A, b, h, b * 256 + qc * 16, 0, 0, lane); }
    }
}

__device__ __forceinline__ void hyena_item(const Params& p, int item, LAS unsigned char* lds) {
    const int tid = threadIdx.x, wid = tid >> 6, lane = tid & 63, a = lane & 31, hh = lane >> 5;
    const bool lat = item < 128;
    const int L = lat ? 2048 : 256, lognb = lat ? 6 : 3, nb = 1 << lognb;
    const int cgp = lat ? item : ((item - 128) >> 1), seq0 = lat ? 0 : ((item - 128) & 1) * 16;
    const int c = cgp * 8 + wid;
    const bf16_t* ut = (const bf16_t*)(p.ws + WS_UT) + (lat ? (size_t)NCTX * 3072 : (size_t)0);
    const size_t sstr = (size_t)3072 * L;
    const int GS = 2 * L + 32;
    const bf16_t* gim = (const bf16_t*)(p.ws + (lat ? WS_GLAT : WS_GCTX));
    LAS unsigned char* zb = lds + wid * 10240;
    LAS unsigned char* gb = lds + 81920 + wid * 8256;
    const float* cw = p.in[16]; const float* cb = p.in[17];
    {
        const float w0 = cw[c], w1 = cw[3072 + c], w2 = cw[6144 + c], bb = cb[c];
        for (int it8 = 0; it8 < 8; ++it8) {
            const int ch = it8 * 64 + lane, col = ch >> 2, part = ch & 3, bl = col >> lognb, i = col & (nb - 1), t0 = 32 * i + 8 * part;
            const bf16_t* ptr = ut + (size_t)(seq0 + bl) * sstr + (size_t)c * L + t0;
            const u32x4 mv = *(const u32x4*)ptr;
            float e[10];
            e[0] = t0 > 0 ? bf2f(ptr[-1]) : 0.f; e[9] = (t0 + 8 < L) ? bf2f(ptr[8]) : 0.f;
            e[1] = bflo(mv.x); e[2] = bfhi(mv.x); e[3] = bflo(mv.y); e[4] = bfhi(mv.y); e[5] = bflo(mv.z); e[6] = bfhi(mv.z); e[7] = bflo(mv.w); e[8] = bfhi(mv.w);
            float o8[8];
#pragma unroll
            for (int j = 0; j < 8; ++j) o8[j] = w0 * e[j] + w1 * e[j + 1] + w2 * e[j + 2] + bb;
            u32x4 ov; ov.x = cvt_pk_bf16(o8[0], o8[1]); ov.y = cvt_pk_bf16(o8[2], o8[3]); ov.z = cvt_pk_bf16(o8[4], o8[5]); ov.w = cvt_pk_bf16(o8[6], o8[7]);
            *(LAS u32x4*)(zb + col * 80 + part * 16) = ov;
        }
    }
    f32x16 acc[4];
#pragma unroll 1
    for (int o = 0; o < 2; ++o) {
        { const u32x4* src = (const u32x4*)(gim + (size_t)(o * 1024 + c) * GS); const int nch = GS / 8;
            for (int i = lane; i < nch; i += 64) *(LAS u32x4*)(gb + i * 16) = src[i]; }
#pragma unroll
        for (int q = 0; q < 4; ++q)
#pragma unroll
            for (int j = 0; j < 16; ++j) acc[q][j] = 0.f;
        for (int k = -(nb - 1); k <= nb - 1; ++k) {
#pragma unroll
            for (int s = 0; s < 2; ++s) {
                const int i0 = L - 32 * k - a + 16 * s + 8 * hh;
                const LAS unsigned* gw = (const LAS unsigned*)gb + (i0 >> 1);
                const unsigned g0 = gw[0], g1 = gw[1], g2 = gw[2], g3 = gw[3], g4 = gw[4];
                const unsigned sh = (unsigned)(i0 & 1) * 2u;
                u32x4 af; af.x = __builtin_amdgcn_alignbyte(g1, g0, sh); af.y = __builtin_amdgcn_alignbyte(g2, g1, sh); af.z = __builtin_amdgcn_alignbyte(g3, g2, sh); af.w = __builtin_amdgcn_alignbyte(g4, g3, sh);
                const bf16x8 afr = as_bf16x8(af);
#pragma unroll
                for (int q = 0; q < 4; ++q) {
                    const int col = 32 * q + a, src = (col & (nb - 1)) - k;
                    u32x4 bv = {0u, 0u, 0u, 0u};
                    if ((unsigned)src < (unsigned)nb) bv = *(const LAS u32x4*)(zb + (col - k) * 80 + 32 * s + 16 * hh);
                    acc[q] = __builtin_amdgcn_mfma_f32_32x32x16_bf16(afr, as_bf16x8(bv), acc[q], 0, 0, 0);
                }
            }
        }
        const int c3 = (o + 1) * 1024 + c;
        const float w0 = cw[c3], w1 = cw[3072 + c3], w2 = cw[6144 + c3], bb = cb[c3];
        if (o == 1) __syncthreads();
#pragma unroll
        for (int q = 0; q < 4; ++q) {
            const int col = 32 * q + a, bl = col >> lognb, i = col & (nb - 1);
            const bf16_t* base = ut + (size_t)(seq0 + bl) * sstr + (size_t)c3 * L + 32 * i;
#pragma unroll
            for (int rg = 0; rg < 4; ++rg) {
                const int a0 = 8 * rg + 4 * hh, t = 32 * i + a0;
                const u32x2 mv = *(const u32x2*)(base + a0);
                float e[6];
                e[0] = t > 0 ? bf2f(base[a0 - 1]) : 0.f; e[5] = (t + 4 < L) ? bf2f(base[a0 + 4]) : 0.f;
                e[1] = bflo(mv.x); e[2] = bfhi(mv.x); e[3] = bflo(mv.y); e[4] = bfhi(mv.y);
                float z[4];
#pragma unroll
                for (int j = 0; j < 4; ++j) z[j] = acc[q][4 * rg + j] * (w0 * e[j] + w1 * e[j + 1] + w2 * e[j + 2] + bb);
                if (o == 0) { u32x2 w; w.x = cvt_pk_bf16(z[0], z[1]); w.y = cvt_pk_bf16(z[2], z[3]); *(LAS u32x2*)(zb + col * 80 + a0 * 2) = w; }
                else {
                    LAS bf16_t* stg = (LAS bf16_t*)lds;
#pragma unroll
                    for (int j = 0; j < 4; ++j) stg[((a0 + j) * 128 + col) * 8 + wid] = f2bf(z[j]);
                }
            }
        }
    }
    __syncthreads();
    {
        bf16_t* O = (bf16_t*)(p.ws + WS_O);
        for (int idx = tid; idx < 4096; idx += 512) {
            const int tin = idx >> 7, col = idx & 127, bl = col >> lognb, i = col & (nb - 1), sq = seq0 + bl;
            const int tok = (lat ? NCTX + sq * 2048 : sq * 256) + 32 * i + tin;
            *(u32x4*)(O + (size_t)tok * D + cgp * 8) = *(const LAS u32x4*)(lds + idx * 16);
        }
    }
    __syncthreads();
}

constexpr int N_PHASES = 22;
__device__ __forceinline__ void run_phase(const Params& p, int ph, unsigned char* shm, int dup = 0) {
    const float* mod = (const float*)(p.ws + WS_MOD);
    float* X = (float*)(p.ws + WS_X); float* Y = (float*)(p.ws + WS_Y);
    const bf16_t* H = (const bf16_t*)(p.ws + WS_H);
    if (ph == 0) { p0_phase(p, shm, dup); return; }
    if (ph == 1) { p1_phase(p, shm, dup); return; }
    const int l = (ph - 2) / 10, sp = (ph - 2) % 10;
    const float* modl = mod + (size_t)l * 3 * 9216;
    if (sp == 0 || sp == 7) {
        const int s = sp == 0 ? 0 : 1;
        EpiSwiglu E; E.O = (bf16_t*)(p.ws + WS_ACT);
        run_gemm(shm, H, (const bf16_t*)(p.ws + WS_WFI + (size_t)(l * 2 + s) * SZ_WFI), 5632, 1024, E);
    } else if (sp == 1 || sp == 8 || sp == 5) {
        EpiResid E; E.Y = Y; E.modl = modl;
        const bool first = (l == 0 && sp == 1);
        E.xa = first ? p.in[0] : X; E.xb = first ? p.in[1] : X + (size_t)NCTX * D;
        const bf16_t* A; const bf16_t* Bt; int K;
        if (sp == 5) { A = (const bf16_t*)(p.ws + WS_O); Bt = (const bf16_t*)(p.ws + (l == 0 ? WS_WO : WS_WHO)); K = 1024; E.gidx = 5; E.gscale = 1.0f; }
        else { const int s = sp == 1 ? 0 : 1; A = (const bf16_t*)(p.ws + WS_ACT); Bt = (const bf16_t*)(p.ws + WS_WFO + (size_t)(l * 2 + s) * SZ_WFO); K = DFF; E.gidx = sp == 1 ? 2 : 8; E.gscale = 0.5f; }
        run_gemm(shm, A, Bt, 1024, K, E);
    } else if (sp == 2 || sp == 6 || sp == 9) {
        const int k = sp == 2 ? 0 : (sp == 6 ? 1 : 2);
        const float* lng = p.in[8] + (size_t)(l * 3 + k) * D; const float* lnb = p.in[9] + (size_t)(l * 3 + k) * D;
        if (sp == 9 && l == 1) row_phase(p, 2, Y, p.out, lng, lnb, modl, 0);
        else if (sp == 9) row_phase(p, 1, Y, X, lng, lnb, modl + 3 * 9216, 0);
        else row_phase(p, 1, Y, X, lng, lnb, modl, sp == 2 ? 3 : 6);
    } else if (sp == 3) {
        if (l == 0) { EpiQKV E; E.Q = (bf16_t*)(p.ws + WS_Q); E.Kb = (bf16_t*)(p.ws + WS_K); E.Vt = (bf16_t*)(p.ws + WS_VT); E.outk = p.out + (size_t)NTOK * D; E.outv = p.out + (size_t)NTOK * D + (size_t)NCTX * D;
            run_gemm(shm, H, (const bf16_t*)(p.ws + WS_WQKV), 3072, 1024, E); }
        else { EpiHyIn E; E.Ut = (bf16_t*)(p.ws + WS_UT); run_gemm(shm, H, (const bf16_t*)(p.ws + WS_WHI), 3072, 1024, E); }
    } else {
        if (l == 0) attn_phase(p);
        else { for (int it = blockIdx.x; it < 128 + 256; it += gridDim.x) hyena_item(p, it, (LAS unsigned char*)shm); }
    }
}

__global__ __launch_bounds__(512, 2) void mega_fwd(Params p) {
    extern __shared__ __attribute__((aligned(16))) unsigned char shm[];
    cg::grid_group grid = cg::this_grid();
#define MK_PHASE(K) if (p.ph_lo <= (K) && (K) < p.ph_hi) { run_phase(p, (K), shm); if ((MK_DUP_MASK >> (K)) & 1u) { grid.sync(); run_phase(p, (K), shm, 1); } if ((K) + 1 < p.ph_hi) grid.sync(); }
    MK_PHASE(0) MK_PHASE(1) MK_PHASE(2) MK_PHASE(3) MK_PHASE(4) MK_PHASE(5) MK_PHASE(6) MK_PHASE(7) MK_PHASE(8) MK_PHASE(9) MK_PHASE(10)
    MK_PHASE(11) MK_PHASE(12) MK_PHASE(13) MK_PHASE(14) MK_PHASE(15) MK_PHASE(16) MK_PHASE(17) MK_PHASE(18) MK_PHASE(19) MK_PHASE(20) MK_PHASE(21)
#undef MK_PHASE
}

extern "C" void kernel_launch(void* const* d_in, const int* in_sizes, int n_in, void* d_out, int out_size, void* d_ws, size_t ws_size, hipStream_t stream) {
    static int grid = 0;
    if (grid == 0) {
        if (n_in != 28 || ws_size < WS_END) { fprintf(stderr, "kernel_launch: need 28 inputs and %zu B of workspace (got %d, %zu)\n", (size_t)WS_END, n_in, ws_size); grid = -1; return; }
        int dev = 0, cus = 0, per_cu = 0;
        hipGetDevice(&dev);
        hipDeviceGetAttribute(&cus, hipDeviceAttributeMultiprocessorCount, dev);
        if (hipFuncSetAttribute((const void*)mega_fwd, hipFuncAttributeMaxDynamicSharedMemorySize, LDS_BYTES) != hipSuccess) { fprintf(stderr, "kernel_launch: hipFuncSetAttribute failed\n"); grid = -1; return; }
        hipOccupancyMaxActiveBlocksPerMultiprocessor(&per_cu, (const void*)mega_fwd, 512, LDS_BYTES);
        if (per_cu < 1) { fprintf(stderr, "kernel_launch: occupancy query says %d blocks per CU\n", per_cu); per_cu = 1; }
        (void)hipGetLastError();
        grid = cus;
    }
    if (grid < 0) return;
    Params p{};
    for (int i = 0; i < 28; ++i) p.in[i] = (const float*)d_in[i];
    p.out = (float*)d_out; p.ws = (unsigned char*)d_ws;
#if MK_LAUNCHES == 1
    p.ph_lo = 0; p.ph_hi = N_PHASES;
    void* args[] = {&p};
    hipError_t e = hipLaunchCooperativeKernel((const void*)mega_fwd, dim3(grid), dim3(512), args, LDS_BYTES, stream);
    if (e != hipSuccess) fprintf(stderr, "cooperative launch failed: %s (grid %d)\n", hipGetErrorString(e), grid);
#else
    for (int ph = 0; ph < N_PHASES; ++ph) {
        p.ph_lo = ph; p.ph_hi = ph + 1;
        hipLaunchKernelGGL(mega_fwd, dim3(grid), dim3(512), LDS_BYTES, stream, p);
    }
#endif
}
```
